# Optimizing an MI355X kernel written in HIP

```python
import jax, jax.numpy as jnp
from jax import lax
import numpy as np

D_MODEL = 1024
BATCH = 8
SEQ = 2048
DEPTH = 4
DEC_BATCH = 128
DEC_SEQ = 8
PAST_LEN = 16384
PAGE_SIZE = 128

E_MIX = 2 * D_MODEL
HEAD_DIM = 128
W_A = 6 * HEAD_DIM
W_B = 4 * HEAD_DIM
W_C = E_MIX - W_A - W_B
N_HEADS_A = W_A // HEAD_DIM
CHUNK = 128
POOL_WINDOWS = (2, 4, 8, 16)
N_POOL_GROUPS = len(POOL_WINDOWS)
POOL_GW = W_B // N_POOL_GROUPS
POOL_BUF = max(POOL_WINDOWS) - 1
CONV_W = 3
CONV_BUF = CONV_W - 1
EPS = 1e-6
IN_WIDTHS = (W_A, W_A, W_A, W_B, W_B, W_C, W_C, W_C, W_C)
IN_TOTAL = sum(IN_WIDTHS)
IN_SPLITS = tuple(int(s) for s in np.cumsum(IN_WIDTHS)[:-1])

kernel_name = "hymba_style_gmlp_pool_shortconv_decode_step"


def rmsnorm(x, g):
    xf = x.astype(jnp.float32)
    y = xf * lax.rsqrt(jnp.mean(xf * xf, axis=-1, keepdims=True) + EPS) * g.astype(jnp.float32)
    return y.astype(x.dtype)


def chunk_gmlp(u, v, v_g, w_s, b_s):
    bt, L, _ = v.shape
    vn = rmsnorm(v, v_g)
    n_chunks = -(-L // CHUNK)
    pad = n_chunks * CHUNK - L
    vp = jnp.pad(vn, ((0, 0), (0, pad), (0, 0)))
    vp = vp.reshape(bt, n_chunks, CHUNK, N_HEADS_A, HEAD_DIM)
    mask = jnp.tril(jnp.ones((CHUNK, CHUNK), dtype=bool))
    w_m = jnp.where(mask[None], w_s, jnp.zeros_like(w_s))
    s = jnp.einsum('hts,bcshd->bcthd', w_m, vp) + b_s.T[None, None, :, :, None]
    s = s.reshape(bt, n_chunks * CHUNK, W_A)[:, :L]
    return u * s, vn


def pool_mixer(p, buf, start_pos, w_pg, pool_scale):
    bt, L, _ = p.shape
    pp = jnp.concatenate([buf, p], axis=1)
    cs = jnp.cumsum(pp.astype(jnp.float32), axis=1)
    cs0 = jnp.pad(cs, ((0, 0), (1, 0), (0, 0)))
    pos = start_pos + jnp.arange(L, dtype=jnp.int32)
    hi = cs0[:, POOL_BUF + 1:POOL_BUF + 1 + L]
    outs = []
    for gi, w in enumerate(POOL_WINDOWS):
        c0, c1 = gi * POOL_GW, (gi + 1) * POOL_GW
        lo = cs0[:, POOL_BUF + 1 - w:POOL_BUF + 1 - w + L, c0:c1]
        cnt = jnp.minimum(pos + 1, w).astype(jnp.float32)[None, :, None]
        mean = (hi[..., c0:c1] - lo) / cnt
        d = (mean - p[..., c0:c1].astype(jnp.float32)).astype(p.dtype)
        outs.append(jnp.einsum('bld,de->ble', d, w_pg[gi]))
    out = jnp.concatenate(outs, axis=-1) * pool_scale
    return out, pp[:, -POOL_BUF:]


def short_conv(xc, bg, cg, buf, conv_w):
    L = xc.shape[1]
    cx = cg * xc
    cp = jnp.concatenate([buf, cx], axis=1)
    y = conv_w[0] * cp[:, 0:L] + conv_w[1] * cp[:, 1:L + 1] + conv_w[2] * cp[:, 2:L + 2]
    return bg * y, cp[:, -CONV_BUF:]


def trunk_layer(x, pool_buf, conv_buf, start_pos, pre_g, w_in, v_g, w_s, b_s,
                w_pg, pool_scale, conv_w, w_out, post_g):
    h = rmsnorm(x, pre_g)
    proj = jnp.einsum('bld,de->ble', h, w_in)
    u, v, z_a, p, z_b, xc, bg, cg, z_c = jnp.split(proj, IN_SPLITS, axis=-1)
    a_out, vn = chunk_gmlp(u, v, v_g, w_s, b_s)
    b_out, new_pool = pool_mixer(p, pool_buf, start_pos, w_pg, pool_scale)
    c_out, new_conv = short_conv(xc, bg, cg, conv_buf, conv_w)
    mix = jnp.concatenate([a_out * jax.nn.silu(z_a), b_out * jax.nn.silu(z_b),
                           c_out * jax.nn.silu(z_c)], axis=-1)
    out = jnp.einsum('ble,ed->bld', mix, w_out)
    return x + rmsnorm(out, post_g), new_pool, new_conv, vn


def setup_inputs(seed: int = 0) -> dict:
    key = jax.random.key(seed)
    ks = jax.random.split(key, 16)
    f = jnp.float32
    nrm = lambda k, s: jax.random.normal(k, s, dtype=f)
    return {
        "x_prompt": nrm(ks[0], (BATCH, SEQ, D_MODEL)),
        "x_sample": nrm(ks[1], (DEC_BATCH, DEC_SEQ, D_MODEL)),
        "state_pool": nrm(ks[2], (DEPTH, DEC_BATCH, POOL_BUF, W_B)),
        "state_conv": nrm(ks[3], (DEPTH, DEC_BATCH, CONV_BUF, W_C)) * 0.5,
        "pre_norm_g": 1.0 + 0.05 * nrm(ks[4], (DEPTH, D_MODEL)),
        "w_in": nrm(ks[5], (DEPTH, D_MODEL, IN_TOTAL)) * D_MODEL ** -0.5,
        "v_norm_g": 1.0 + 0.05 * nrm(ks[6], (DEPTH, W_A)),
        "w_spatial": nrm(ks[7], (DEPTH, N_HEADS_A, CHUNK, CHUNK)) * CHUNK ** -0.5,
        "b_spatial": 1.0 + 0.1 * nrm(ks[8], (DEPTH, N_HEADS_A, CHUNK)),
        "w_pool_group": nrm(ks[9], (DEPTH, N_POOL_GROUPS, POOL_GW, POOL_GW)) * POOL_GW ** -0.5,
        "pool_scale": 1.0 + 0.1 * nrm(ks[10], (DEPTH, W_B)),
        "conv_w": nrm(ks[11], (DEPTH, CONV_W, W_C)) * CONV_W ** -0.5,
        "w_out": nrm(ks[12], (DEPTH, E_MIX, D_MODEL)) * E_MIX ** -0.5,
        "post_norm_g": 1.0 + 0.05 * nrm(ks[13], (DEPTH, D_MODEL)),
    }


def reference(x_prompt, x_sample, state_pool, state_conv, pre_norm_g, w_in, v_norm_g,
              w_spatial, b_spatial, w_pool_group, pool_scale, conv_w, w_out, post_norm_g):
    hp = x_prompt
    hs = x_sample
    pool_p, conv_p, pool_s, conv_s, v_s = [], [], [], [], []
    zero_pool = jnp.zeros((x_prompt.shape[0], POOL_BUF, W_B), x_prompt.dtype)
    zero_conv = jnp.zeros((x_prompt.shape[0], CONV_BUF, W_C), x_prompt.dtype)
    for l in range(DEPTH):
        params = (pre_norm_g[l], w_in[l], v_norm_g[l], w_spatial[l], b_spatial[l],
                  w_pool_group[l], pool_scale[l], conv_w[l], w_out[l], post_norm_g[l])
        hp, npool, nconv, _ = trunk_layer(hp, zero_pool, zero_conv, 0, *params)
        pool_p.append(npool)
        conv_p.append(nconv)
        hs, npool, nconv, vn = trunk_layer(hs, state_pool[l], state_conv[l], PAST_LEN, *params)
        pool_s.append(npool)
        conv_s.append(nconv)
        v_s.append(vn)
    return (hp, hs, jnp.stack(pool_p), jnp.stack(conv_p), jnp.stack(pool_s),
            jnp.stack(conv_s), jnp.stack(v_s))
```

```cpp
#include <hip/hip_runtime.h>
#include <hip/hip_cooperative_groups.h>
#include <cstdio>
#include <cstdint>
namespace cg = cooperative_groups;

#define LAS __attribute__((address_space(3)))
typedef unsigned short bf16_t;
typedef short bf16x8 __attribute__((ext_vector_type(8)));
typedef float f32x4 __attribute__((ext_vector_type(4)));
typedef unsigned u32x4 __attribute__((ext_vector_type(4)));
typedef unsigned u32x2 __attribute__((ext_vector_type(2)));

constexpr int TP = 16384, TS = 1024, T = TP + TS, D = 1024, NIN = 6400, EM = 2048, DEPTH = 4;
constexpr int WA = 768, WB = 512, WC = 768;
constexpr int C_U = 0, C_V = 768, C_ZA = 1536, C_P = 2304, C_ZB = 2816, C_XC = 3328, C_BG = 4096, C_CG = 4864, C_ZC = 5632;
constexpr float EPS = 1e-6f;
constexpr size_t O_Y = 0, O_NSPP = (size_t)T * D, O_NSCP = O_NSPP + 4 * 8 * 15 * 512, O_NSPS = O_NSCP + 4 * 8 * 2 * 768,
                 O_NSCS = O_NSPS + 4 * 128 * 15 * 512, O_NSV = O_NSCS + 4 * 128 * 2 * 768, O_END = O_NSV + 4 * 128 * 8 * 768;
constexpr size_t MiB = 1u << 20;
constexpr size_t WS_CTL = 0, WS_W1T = 1 * MiB, WS_W2T = 51 * MiB, WS_WPG = 67 * MiB, WS_WSM = 67 * MiB + 512 * 1024, WS_VSS = 69 * MiB,
                 WS_H = 70 * MiB, WS_MIX = 104 * MiB, WS_PROJ = 172 * MiB, WS_OUT = WS_PROJ, WS_END = WS_PROJ + (size_t)T * NIN * 2;
constexpr int LDS_BYTES = 131072 + 4096;
constexpr int NPHASE = 1 + 4 * DEPTH;

namespace pg8 {
constexpr int BM = 256, BK = 64, HALF = 128, HTB = HALF * BK * 2, STAGE_BYTES = 8 * HTB, NXCD = 8, WGM = 8;
__host__ __device__ __forceinline__ int lds_byte(int r, int c) { const int st = (r >> 4) * 2 + (c >> 5), rr = r & 15, cc = c & 31, ob = rr * 64 + cc * 2; return st * 1024 + (ob ^ (((ob >> 9) & 1) << 5)); }
__host__ __device__ __forceinline__ void stage_rc(int b, int& R, int& C) { const int st = b / 1024, sb = b % 1024, swz = sb ^ (((sb >> 9) & 1) << 5); R = (st >> 1) * 16 + swz / 64; C = (st & 1) * 32 + (swz % 64) / 2; }
__host__ __device__ __forceinline__ int perm32(int rho) { const int n = rho >> 4, i = rho & 15; return 8 * (i >> 2) + 4 * n + (i & 3); }
struct Unit { int pm, pn; };
struct Gemm { const bf16_t* A; const bf16_t* Bt; int M, N, K; };
struct StaticOrder {
    int nM, nN, nwg, G, c;
    __host__ __device__ void init(int M, int N, int G_, int c_) { nM = M / BM; nN = N / BM; nwg = nM * nN; G = G_; c = c_; }
    __host__ __device__ bool next(int i, Unit& u) const {
        const long L = (long)i * G + c; if (L >= nwg) return false;
        int wgid = (int)L; { const int q = nwg / NXCD, r = nwg % NXCD, xcd = wgid % NXCD, off = wgid / NXCD; wgid = (xcd < r ? xcd * (q + 1) : r * (q + 1) + (xcd - r) * q) + off; }
        const int nig = WGM * nN, gid = wgid / nig, fm = gid * WGM, gsz = (nM - fm) < WGM ? (nM - fm) : WGM;
        u.pm = fm + ((wgid % nig) % gsz); u.pn = (wgid % nig) / gsz; return true;
    }
    __device__ __forceinline__ void a_ready(const Unit&) const {}
    __device__ __forceinline__ void done(const Unit&) const {}
};
__device__ __forceinline__ unsigned cvt_pk_bf16(float lo, float hi) { unsigned r; asm volatile("v_cvt_pk_bf16_f32 %0, %1, %2" : "=v"(r) : "v"(lo), "v"(hi)); return r; }

struct EpiProj {
    static constexpr bool PERM = true, AFTER_DRAIN = false;
    bf16_t* O; float* vss;
    __device__ __forceinline__ void operator()(const f32x4 (&acc)[2][2][4][2], const Unit& u, int wr, int wc, int fr, int fq) const {
        const int row0 = u.pm * BM + wr * 64 + fr; const int col0 = u.pn * BM + wc * 32 + 8 * fq;
#pragma unroll
        for (int ai = 0; ai < 2; ++ai)
#pragma unroll
            for (int m = 0; m < 4; ++m) { bf16_t* rowp = O + (size_t)(row0 + ai * HALF + m * 16) * NIN + col0;
#pragma unroll
                for (int bj = 0; bj < 2; ++bj) { const f32x4 v0 = acc[ai][bj][m][0], v1 = acc[ai][bj][m][1];
                    u32x4 w; w.x = cvt_pk_bf16(v0[0], v0[1]); w.y = cvt_pk_bf16(v0[2], v0[3]); w.z = cvt_pk_bf16(v1[0], v1[1]); w.w = cvt_pk_bf16(v1[2], v1[3]);
                    *(u32x4*)(rowp + bj * HALF) = w; } }
        if (u.pn >= 3 && u.pn < 6) {
            float* dst = vss + (size_t)((u.pn - 3) * 4 + wc) * T;
#pragma unroll
            for (int ai = 0; ai < 2; ++ai)
#pragma unroll
                for (int m = 0; m < 4; ++m) { float s = 0.f;
#pragma unroll
                    for (int bj = 0; bj < 2; ++bj)
#pragma unroll
                        for (int n = 0; n < 2; ++n) { const f32x4 x = acc[ai][bj][m][n]; s += (x[0] * x[0] + x[1] * x[1]) + (x[2] * x[2] + x[3] * x[3]); }
                    s += __shfl_xor(s, 16); s += __shfl_xor(s, 32);
                    if (fq == 0) dst[row0 + ai * HALF + m * 16] = s; }
        }
    }
};
struct EpiOutF32 {
    static constexpr bool PERM = false, AFTER_DRAIN = false;
    float* O;
    __device__ __forceinline__ void operator()(const f32x4 (&acc)[2][2][4][2], const Unit& u, int wr, int wc, int fr, int fq) const {
        const int row0 = u.pm * BM + wr * 64 + fr; const int col0 = u.pn * BM + wc * 32 + 4 * fq;
#pragma unroll
        for (int ai = 0; ai < 2; ++ai)
#pragma unroll
            for (int m = 0; m < 4; ++m) { float* rowp = O + (size_t)(row0 + ai * HALF + m * 16) * D + col0;
#pragma unroll
                for (int bj = 0; bj < 2; ++bj)
#pragma unroll
                    for (int n = 0; n < 2; ++n) *(f32x4*)(rowp + bj * HALF + n * 16) = acc[ai][bj][m][n]; }
    }
};

template <class Epi, class Sched, bool ALIGN_EPI = false, bool SP2 = false>
__device__ __forceinline__ void gemm_phase(LAS unsigned char* lds, const Gemm g, const Sched& S, const Epi& E) {
    int tid_ = threadIdx.x; asm volatile("" : "+v"(tid_));
    const int tid = tid_, wid = __builtin_amdgcn_readfirstlane(tid >> 6), lane = tid & 63, wr = wid >> 2, wc = wid & 3, fr = lane & 15, fq = lane >> 4;
    const int K = g.K, nt = K / BK;
    unsigned voffA[2], voffB[2];
#pragma unroll
    for (int i = 0; i < 2; ++i) { int R, C; stage_rc(tid * 16 + i * 8192, R, C); const int Rb = Epi::PERM ? ((R & ~31) + perm32(R & 31)) : R;
        voffA[i] = (unsigned)(R * K + C) * 2u; voffB[i] = (unsigned)(Rb * K + C) * 2u; }
    const size_t kstep = (size_t)(BK * 2);
    const size_t hstep = (size_t)HALF * K * 2;
    const size_t tstep = 2 * hstep;
    const unsigned ldsw = (unsigned)wid * 1024u;
    const int aoff = lds_byte(wr * 64 + fr, fq * 8), boff = lds_byte(wc * 32 + fr, fq * 8);
#define PG8_SA(b, h) (((b) * 2 + (h)) * HTB)
#define PG8_SB(b, h) ((4 + (b) * 2 + (h)) * HTB)
#define PG8_STAGE(bufoff, gbase, voff) do { _Pragma("unroll") for (int _i = 0; _i < 2; ++_i) \
        __builtin_amdgcn_global_load_lds((const unsigned*)((const char*)(gbase) + (voff)[_i]), (LAS unsigned*)(lds + (bufoff) + ldsw + _i * 8192), 16, 0, 0); } while (0)
#define PG8_LDA(dst, b, h) do { _Pragma("unroll") for (int m = 0; m < 4; ++m) _Pragma("unroll") for (int k = 0; k < 2; ++k) dst[m][k] = *(const LAS bf16x8*)(lds + PG8_SA(b, h) + aoff + m * 2048 + k * 1024); } while (0)
#define PG8_LDB(dst, b, h) do { _Pragma("unroll") for (int n = 0; n < 2; ++n) _Pragma("unroll") for (int k = 0; k < 2; ++k) dst[n][k] = *(const LAS bf16x8*)(lds + PG8_SB(b, h) + boff + n * 2048 + k * 1024); } while (0)
#define PG8_MMA(ai, bj, At, Bt) do { __builtin_amdgcn_s_setprio(1); _Pragma("unroll") for (int m = 0; m < 4; ++m) _Pragma("unroll") for (int n = 0; n < 2; ++n) _Pragma("unroll") for (int k = 0; k < 2; ++k) \
        acc[ai][bj][m][n] = __builtin_amdgcn_mfma_f32_16x16x32_bf16(Bt[n][k], At[m][k], acc[ai][bj][m][n], 0, 0, 0); __builtin_amdgcn_s_setprio(0); } while (0)
#define PG8_WAIT_V(n) asm volatile("s_waitcnt vmcnt(" #n ")" ::: "memory")
#define PG8_WAIT_L(n) asm volatile("s_waitcnt lgkmcnt(" #n ")" ::: "memory")
#define PG8_BAR __builtin_amdgcn_s_barrier()
#define PG8_SCHED __builtin_amdgcn_sched_barrier(0)
    Unit cur, nxt; int ui = 0;
    if (!S.next(0, cur)) return;
    f32x4 acc[2][2][4][2];
#pragma unroll
    for (int a = 0; a < 2; ++a)
#pragma unroll
        for (int b = 0; b < 2; ++b)
#pragma unroll
            for (int m = 0; m < 4; ++m)
#pragma unroll
                for (int n = 0; n < 2; ++n) acc[a][b][m][n] = (f32x4){0.f, 0.f, 0.f, 0.f};
    bf16x8 At[4][2], B0[2][2], B1[2][2];
    const char* cA = (const char*)g.A + (size_t)cur.pm * tstep; const char* cB = (const char*)g.Bt + (size_t)cur.pn * tstep;
    S.a_ready(cur);
    if constexpr (SP2) {
        PG8_STAGE(PG8_SB(0, 0), cB, voffB); PG8_STAGE(PG8_SB(0, 1), cB + hstep, voffB); PG8_STAGE(PG8_SA(0, 0), cA, voffA); PG8_STAGE(PG8_SA(0, 1), cA + hstep, voffA);
        if (wr == 1) PG8_BAR;
        PG8_WAIT_V(2); PG8_BAR;
        PG8_STAGE(PG8_SB(1, 0), cB + kstep, voffB); PG8_STAGE(PG8_SA(1, 0), cA + kstep, voffA); PG8_STAGE(PG8_SB(1, 1), cB + hstep + kstep, voffB);
        PG8_WAIT_V(6); PG8_BAR;
    } else {
        PG8_STAGE(PG8_SB(0, 0), cB, voffB); PG8_STAGE(PG8_SA(0, 0), cA, voffA); PG8_STAGE(PG8_SB(0, 1), cB + hstep, voffB); PG8_STAGE(PG8_SA(0, 1), cA + hstep, voffA);
        if (wr == 1) PG8_BAR;
        PG8_WAIT_V(4); PG8_BAR;
        PG8_STAGE(PG8_SB(1, 0), cB + kstep, voffB); PG8_STAGE(PG8_SA(1, 0), cA + kstep, voffA); PG8_STAGE(PG8_SB(1, 1), cB + hstep + kstep, voffB);
        PG8_WAIT_V(6); PG8_BAR;
    }
    for (;;) {
        const bool has_next = S.next(ui + 1, nxt);
        const char* nA = has_next ? (const char*)g.A + (size_t)nxt.pm * tstep : cA; const char* nB = has_next ? (const char*)g.Bt + (size_t)nxt.pn * tstep : cB;
        for (int t = 0; t < nt; t += 2) {
            const bool last = (t == nt - 2);
            const char* a1 = cA + (size_t)(t + 1) * kstep;
            const char* a2 = last ? nA : cA + (size_t)(t + 2) * kstep; const char* b2 = last ? nB : cB + (size_t)(t + 2) * kstep;
            const char* a3 = a2 + kstep; const char* b3 = b2 + kstep;
            if (last && has_next) S.a_ready(nxt);
            if constexpr (SP2) {
            PG8_LDB(B0, 0, 0); PG8_LDB(B1, 0, 1); PG8_SCHED; PG8_LDA(At, 0, 0); PG8_STAGE(PG8_SA(1, 1), a1 + hstep, voffA);
            PG8_WAIT_V(8); PG8_WAIT_L(0); PG8_BAR; PG8_MMA(0, 0, At, B0); PG8_MMA(0, 1, At, B1); PG8_BAR; PG8_SCHED;
            PG8_LDA(At, 0, 1); PG8_STAGE(PG8_SB(0, 0), b2, voffB); PG8_STAGE(PG8_SB(0, 1), b2 + hstep, voffB); PG8_STAGE(PG8_SA(0, 0), a2, voffA);
            PG8_WAIT_V(8); PG8_WAIT_L(0); PG8_BAR; PG8_MMA(1, 0, At, B0); PG8_MMA(1, 1, At, B1); PG8_BAR; PG8_SCHED;
            PG8_LDB(B0, 1, 0); PG8_LDB(B1, 1, 1); PG8_SCHED; PG8_LDA(At, 1, 0); PG8_STAGE(PG8_SA(0, 1), a2 + hstep, voffA);
            PG8_WAIT_V(8); PG8_WAIT_L(0); PG8_BAR; PG8_MMA(0, 0, At, B0); PG8_MMA(0, 1, At, B1); PG8_BAR; PG8_SCHED;
            PG8_LDA(At, 1, 1); PG8_STAGE(PG8_SB(1, 0), b3, voffB); PG8_STAGE(PG8_SB(1, 1), b3 + hstep, voffB); PG8_STAGE(PG8_SA(1, 0), a3, voffA);
            PG8_WAIT_V(8); PG8_WAIT_L(0); PG8_BAR; PG8_MMA(1, 0, At, B0); PG8_MMA(1, 1, At, B1); PG8_BAR; PG8_SCHED;
            } else {
            PG8_LDB(B0, 0, 0); PG8_SCHED; PG8_LDA(At, 0, 0); PG8_STAGE(PG8_SA(1, 1), a1 + hstep, voffA);
            PG8_WAIT_L(8); PG8_BAR; PG8_WAIT_L(0); PG8_MMA(0, 0, At, B0); PG8_BAR; PG8_SCHED;
            PG8_LDB(B1, 0, 1); PG8_STAGE(PG8_SB(0, 0), b2, voffB);
            PG8_BAR; PG8_WAIT_L(0); PG8_MMA(0, 1, At, B1); PG8_BAR;
            PG8_LDA(At, 0, 1); PG8_STAGE(PG8_SA(0, 0), a2, voffA);
            PG8_BAR; PG8_WAIT_L(0); PG8_MMA(1, 0, At, B0); PG8_BAR; PG8_SCHED;
            PG8_STAGE(PG8_SB(0, 1), b2 + hstep, voffB);
            PG8_WAIT_V(6); PG8_BAR; PG8_MMA(1, 1, At, B1); PG8_BAR;
            PG8_LDB(B0, 1, 0); PG8_SCHED; PG8_LDA(At, 1, 0); PG8_STAGE(PG8_SA(0, 1), a2 + hstep, voffA);
            PG8_WAIT_L(8); PG8_BAR; PG8_WAIT_L(0); PG8_MMA(0, 0, At, B0); PG8_BAR; PG8_SCHED;
            PG8_LDB(B1, 1, 1); PG8_STAGE(PG8_SB(1, 0), b3, voffB);
            PG8_BAR; PG8_WAIT_L(0); PG8_MMA(0, 1, At, B1); PG8_BAR;
            PG8_LDA(At, 1, 1); PG8_STAGE(PG8_SA(1, 0), a3, voffA);
            PG8_BAR; PG8_WAIT_L(0); PG8_MMA(1, 0, At, B0); PG8_BAR; PG8_SCHED;
            PG8_STAGE(PG8_SB(1, 1), b3 + hstep, voffB);
            PG8_WAIT_V(6); PG8_BAR; PG8_MMA(1, 1, At, B1); PG8_BAR;
            }
        }
        if constexpr (ALIGN_EPI) { if (wr == 0) PG8_BAR; }
        if constexpr (!Epi::AFTER_DRAIN) { E(acc, cur, wr, wc, fr, fq); S.done(cur); }
        if (!has_next) break;
#pragma unroll
        for (int a = 0; a < 2; ++a)
#pragma unroll
            for (int b = 0; b < 2; ++b)
#pragma unroll
                for (int m = 0; m < 4; ++m)
#pragma unroll
                    for (int n = 0; n < 2; ++n) acc[a][b][m][n] = (f32x4){0.f, 0.f, 0.f, 0.f};
        cur = nxt; cA = nA; cB = nB; ++ui;
        if constexpr (ALIGN_EPI) { if (wr == 1) PG8_BAR; }
    }
    PG8_WAIT_V(0);
    if constexpr (!ALIGN_EPI) { if (wr == 0) PG8_BAR; }
    PG8_BAR;
#undef PG8_SA
#undef PG8_SB
#undef PG8_STAGE
#undef PG8_LDA
#undef PG8_LDB
#undef PG8_MMA
#undef PG8_WAIT_V
#undef PG8_WAIT_L
#undef PG8_BAR
#undef PG8_SCHED
}
}

#define LDS_WAIT() asm volatile("s_waitcnt lgkmcnt(0)" ::: "memory")
__device__ __forceinline__ unsigned f2bf(float f) { unsigned u = __builtin_bit_cast(unsigned, f); return (u + 0x7fffu + ((u >> 16) & 1u)) >> 16; }
__device__ __forceinline__ unsigned pk2(float lo, float hi) { return f2bf(lo) | (f2bf(hi) << 16); }
__device__ __forceinline__ float wave_sum(float v) {
#pragma unroll
    for (int o = 1; o < 64; o <<= 1) v += __shfl_xor(v, o);
    return v;
}
__device__ __forceinline__ float silu(float x) { return x / (1.f + __expf(-x)); }
__device__ __forceinline__ void ld8(const bf16_t* p, float (&f)[8]) {
    const u32x4 w = *(const u32x4*)p;
    f[0] = __uint_as_float(w.x << 16); f[1] = __uint_as_float(w.x & 0xffff0000u); f[2] = __uint_as_float(w.y << 16); f[3] = __uint_as_float(w.y & 0xffff0000u);
    f[4] = __uint_as_float(w.z << 16); f[5] = __uint_as_float(w.z & 0xffff0000u); f[6] = __uint_as_float(w.w << 16); f[7] = __uint_as_float(w.w & 0xffff0000u);
}
__device__ __forceinline__ void ld4(const bf16_t* p, float (&f)[4]) {
    const u32x2 w = *(const u32x2*)p;
    f[0] = __uint_as_float(w.x << 16); f[1] = __uint_as_float(w.x & 0xffff0000u); f[2] = __uint_as_float(w.y << 16); f[3] = __uint_as_float(w.y & 0xffff0000u);
}
__device__ __forceinline__ void ld8f(const float* p, float (&f)[8]) {
    const f32x4 a = *(const f32x4*)p, b = *(const f32x4*)(p + 4);
    f[0] = a[0]; f[1] = a[1]; f[2] = a[2]; f[3] = a[3]; f[4] = b[0]; f[5] = b[1]; f[6] = b[2]; f[7] = b[3];
}
__device__ __forceinline__ void st8f(float* p, const float (&f)[8]) {
    *(f32x4*)p = (f32x4){f[0], f[1], f[2], f[3]}; *(f32x4*)(p + 4) = (f32x4){f[4], f[5], f[6], f[7]};
}
__device__ __forceinline__ u32x4 pk8(const float (&f)[8]) {
    u32x4 w; w.x = pk2(f[0], f[1]); w.y = pk2(f[2], f[3]); w.z = pk2(f[4], f[5]); w.w = pk2(f[6], f[7]); return w;
}

struct Args { const float* in[14]; float* out; unsigned char* ws; int ph_lo, ph_hi; };

__device__ __forceinline__ void p0_transpose_item(const float* W, int K, int N, bf16_t* WT, LAS float* scr, int item, int lane) {
    const int nblk = N / 32, kb = item / nblk, nb = item % nblk, k0 = 64 * kb, n0 = 32 * nb;
#pragma unroll 8
    for (int i = 0; i < 32; ++i) { const int kk = 2 * i + (lane >> 5); scr[kk * 33 + (lane & 31)] = W[(size_t)(k0 + kk) * N + n0 + (lane & 31)]; }
    LDS_WAIT(); asm volatile("" ::: "memory");
    const int c = lane & 7;
#pragma unroll
    for (int j = 0; j < 4; ++j) { const int n = (lane >> 3) + 8 * j; const LAS float* s = scr + (8 * c) * 33 + n;
        u32x4 o; o.x = pk2(s[0 * 33], s[1 * 33]); o.y = pk2(s[2 * 33], s[3 * 33]); o.z = pk2(s[4 * 33], s[5 * 33]); o.w = pk2(s[6 * 33], s[7 * 33]);
        *(u32x4*)(WT + (size_t)(n0 + n) * K + k0 + 8 * c) = o; }
    LDS_WAIT(); asm volatile("" ::: "memory");
}

__device__ __forceinline__ void row_norm(const float* xrow, const float* orow, const float* gpost, float* yout, const float* gpre, bf16_t* hrow, int lane) {
    f32x4 v[4];
#pragma unroll
    for (int j = 0; j < 4; ++j) v[j] = ((const f32x4*)xrow)[lane + 64 * j];
    if (orow) {
        f32x4 o[4]; float s = 0.f;
#pragma unroll
        for (int j = 0; j < 4; ++j) { o[j] = ((const f32x4*)orow)[lane + 64 * j]; s += (o[j][0] * o[j][0] + o[j][1] * o[j][1]) + (o[j][2] * o[j][2] + o[j][3] * o[j][3]); }
        const float rs = rsqrtf(wave_sum(s) * (1.f / D) + EPS);
#pragma unroll
        for (int j = 0; j < 4; ++j) { const f32x4 g = ((const f32x4*)gpost)[lane + 64 * j]; v[j] = v[j] + o[j] * rs * g; ((f32x4*)yout)[lane + 64 * j] = v[j]; }
    }
    if (hrow) {
        float s = 0.f;
#pragma unroll
        for (int j = 0; j < 4; ++j) s += (v[j][0] * v[j][0] + v[j][1] * v[j][1]) + (v[j][2] * v[j][2] + v[j][3] * v[j][3]);
        const float rs = rsqrtf(wave_sum(s) * (1.f / D) + EPS);
#pragma unroll
        for (int j = 0; j < 4; ++j) { const f32x4 g = ((const f32x4*)gpre)[lane + 64 * j]; const f32x4 h = v[j] * rs * g;
            u32x2 w; w.x = pk2(h[0], h[1]); w.y = pk2(h[2], h[3]); ((u32x2*)hrow)[lane + 64 * j] = w; }
    }
}

constexpr int LDT = 136;
__device__ __forceinline__ void mix_phase(const Args& a, int l, unsigned char* lds) {
    int tid_ = threadIdx.x; asm volatile("" : "+v"(tid_));
    const int tid = tid_, lane = tid & 63, wid = tid >> 6, fr = lane & 15, fq = lane >> 4;
    const int q = tid & 15, r0 = tid >> 4;
    const int wr32 = (wid >> 1) * 32, wc64 = (wid & 1) * 64;
    bf16_t* tileL = (bf16_t*)lds;
    float* rsS = (float*)(lds + 128 * LDT * 2);
    const bf16_t* PROJ = (const bf16_t*)(a.ws + WS_PROJ);
    bf16_t* MIX = (bf16_t*)(a.ws + WS_MIX);
    const float* vss = (const float*)(a.ws + WS_VSS);
    const bf16_t* Wpg = (const bf16_t*)(a.ws + WS_WPG);
    const bf16_t* Wsm = (const bf16_t*)(a.ws + WS_WSM);
    float* out = a.out;
    for (int job = blockIdx.x; job < 136 * 16; job += gridDim.x) {
        const int tile = job >> 4, slice = job & 15;
        const bool isS = tile >= 128;
        const int mbase = tile * 128;
        __syncthreads();
        if (slice >= 10) {
            const int c = (slice - 10) * 128 + q * 8;
            float w0[8], w1[8], w2[8];
            ld8f(a.in[11] + (size_t)(l * 3 + 0) * WC + c, w0); ld8f(a.in[11] + (size_t)(l * 3 + 1) * WC + c, w1); ld8f(a.in[11] + (size_t)(l * 3 + 2) * WC + c, w2);
            for (int it = 0; it < 4; ++it) {
                const int r = r0 + 32 * it, m = mbase + r;
                const bf16_t* pr = PROJ + (size_t)m * NIN;
                float xc[8], cgv[8], cx0[8], cx1[8], cx2[8], bg[8], zc[8];
                ld8(pr + C_XC + c, xc); ld8(pr + C_CG + c, cgv); ld8(pr + C_BG + c, bg); ld8(pr + C_ZC + c, zc);
#pragma unroll
                for (int i = 0; i < 8; ++i) { cx0[i] = cgv[i] * xc[i]; cx1[i] = 0.f; cx2[i] = 0.f; }
                int t, b;
                if (!isS) { t = m & 2047; b = m >> 11; } else { const int ms = m - TP; t = ms & 7; b = ms >> 3; }
                if (t >= 1) { ld8(pr - NIN + C_XC + c, xc); ld8(pr - NIN + C_CG + c, cgv);
#pragma unroll
                    for (int i = 0; i < 8; ++i) cx1[i] = cgv[i] * xc[i]; }
                else if (isS) ld8f(a.in[3] + (size_t)((l * 128 + b) * 2 + 1) * WC + c, cx1);
                if (t >= 2) { ld8(pr - 2 * NIN + C_XC + c, xc); ld8(pr - 2 * NIN + C_CG + c, cgv);
#pragma unroll
                    for (int i = 0; i < 8; ++i) cx2[i] = cgv[i] * xc[i]; }
                else if (isS) ld8f(a.in[3] + (size_t)((l * 128 + b) * 2 + t) * WC + c, cx2);
                float o[8];
#pragma unroll
                for (int i = 0; i < 8; ++i) o[i] = bg[i] * (w0[i] * cx2[i] + w1[i] * cx1[i] + w2[i] * cx0[i]) * silu(zc[i]);
                *(u32x4*)(MIX + (size_t)m * EM + 1280 + c) = pk8(o);
                if (!isS) { if (t >= 2046) st8f(out + O_NSCP + (size_t)((l * 8 + b) * 2 + (t - 2046)) * WC + c, cx0); }
                else { if (t >= 6) st8f(out + O_NSCS + (size_t)((l * 128 + b) * 2 + (t - 6)) * WC + c, cx0); }
            }
        } else if (slice >= 6) {
            const int g = slice - 6, w = 2 << g, c = g * 128 + q * 8;
            for (int it = 0; it < 4; ++it) {
                const int r = r0 + 32 * it, m = mbase + r;
                const bf16_t* pr = PROJ + (size_t)m * NIN + C_P + c;
                float sum[8], pc[8], v[8]; float inv;
                ld8(pr, pc);
#pragma unroll
                for (int i = 0; i < 8; ++i) sum[i] = pc[i];
                if (!isS) {
                    const int t = m & 2047, b = m >> 11; const int n = (t + 1) < w ? (t + 1) : w;
                    for (int i = 1; i < n; ++i) { ld8(pr - (size_t)i * NIN, v);
#pragma unroll
                        for (int k = 0; k < 8; ++k) sum[k] += v[k]; }
                    inv = 1.f / (float)n;
                    if (t >= 2033) st8f(out + O_NSPP + (size_t)((l * 8 + b) * 15 + (t - 2033)) * WB + c, pc);
                } else {
                    const int ms = m - TP, t = ms & 7, b = ms >> 3;
                    for (int i = 1; i < w; ++i) {
                        if (t - i >= 0) ld8(pr - (size_t)i * NIN, v); else ld8f(a.in[2] + (size_t)((l * 128 + b) * 15 + 15 + t - i) * WB + c, v);
#pragma unroll
                        for (int k = 0; k < 8; ++k) sum[k] += v[k]; }
                    inv = 1.f / (float)w;
                    st8f(out + O_NSPS + (size_t)((l * 128 + b) * 15 + 7 + t) * WB + c, pc);
                }
                float d[8];
#pragma unroll
                for (int i = 0; i < 8; ++i) d[i] = sum[i] * inv - pc[i];
                *(u32x4*)(tileL + r * LDT + q * 8) = pk8(d);
            }
            if (isS) {
                for (int idx = tid; idx < 16 * 7 * 16; idx += 512) {
                    const int sq = idx / 112, rem = idx % 112, j = rem >> 4, qq = rem & 15, b = (tile - 128) * 16 + sq;
                    float v[8]; ld8f(a.in[2] + (size_t)((l * 128 + b) * 15 + 8 + j) * WB + g * 128 + qq * 8, v);
                    st8f(out + O_NSPS + (size_t)((l * 128 + b) * 15 + j) * WB + g * 128 + qq * 8, v);
                }
            }
            __syncthreads();
            f32x4 acc[2][4];
#pragma unroll
            for (int mt = 0; mt < 2; ++mt)
#pragma unroll
                for (int nt = 0; nt < 4; ++nt) acc[mt][nt] = (f32x4){0.f, 0.f, 0.f, 0.f};
            const bf16_t* wb = Wpg + (size_t)(l * 4 + g) * 128 * 128;
#pragma unroll
            for (int ks = 0; ks < 4; ++ks) {
                bf16x8 af[2], bfr[4];
#pragma unroll
                for (int mt = 0; mt < 2; ++mt) af[mt] = *(const bf16x8*)(tileL + (wr32 + mt * 16 + fr) * LDT + ks * 32 + fq * 8);
#pragma unroll
                for (int nt = 0; nt < 4; ++nt) bfr[nt] = *(const bf16x8*)(wb + (size_t)(wc64 + nt * 16 + fr) * 128 + ks * 32 + fq * 8);
#pragma unroll
                for (int mt = 0; mt < 2; ++mt)
#pragma unroll
                    for (int nt = 0; nt < 4; ++nt) acc[mt][nt] = __builtin_amdgcn_mfma_f32_16x16x32_bf16(bfr[nt], af[mt], acc[mt][nt], 0, 0, 0);
            }
#pragma unroll
            for (int mt = 0; mt < 2; ++mt) {
                const int m = mbase + wr32 + mt * 16 + fr;
#pragma unroll
                for (int nt = 0; nt < 4; ++nt) {
                    const int e = g * 128 + wc64 + nt * 16 + fq * 4;
                    float z[4]; ld4(PROJ + (size_t)m * NIN + C_ZB + e, z);
                    const f32x4 ps = *(const f32x4*)(a.in[10] + (size_t)l * WB + e);
                    u32x2 o; o.x = pk2(acc[mt][nt][0] * ps[0] * silu(z[0]), acc[mt][nt][1] * ps[1] * silu(z[1]));
                    o.y = pk2(acc[mt][nt][2] * ps[2] * silu(z[2]), acc[mt][nt][3] * ps[3] * silu(z[3]));
                    *(u32x2*)(MIX + (size_t)m * EM + 768 + e) = o;
                }
            }
        } else {
            const int h = slice, c = h * 128 + q * 8;
            if (tid < 128) { const int m = mbase + tid; float s = 0.f;
#pragma unroll
                for (int p = 0; p < 12; ++p) s += vss[(size_t)p * T + m];
                rsS[tid] = rsqrtf(s * (1.f / WA) + EPS); }
            __syncthreads();
            float gv[8]; ld8f(a.in[6] + (size_t)l * WA + c, gv);
            if (!isS) {
                for (int it = 0; it < 4; ++it) {
                    const int r = r0 + 32 * it, m = mbase + r;
                    float v[8]; ld8(PROJ + (size_t)m * NIN + C_V + c, v);
                    const float rs = rsS[r];
#pragma unroll
                    for (int i = 0; i < 8; ++i) tileL[(q * 8 + i) * LDT + r] = (bf16_t)f2bf(v[i] * rs * gv[i]);
                }
                __syncthreads();
                f32x4 acc[2][4];
#pragma unroll
                for (int mt = 0; mt < 2; ++mt)
#pragma unroll
                    for (int nt = 0; nt < 4; ++nt) acc[mt][nt] = (f32x4){0.f, 0.f, 0.f, 0.f};
                const bf16_t* wa = Wsm + (size_t)(l * 6 + h) * 128 * 128;
                const int nks = (wid >> 1) + 1;
                for (int ks = 0; ks < nks; ++ks) {
                    bf16x8 af[2], bfr[4];
#pragma unroll
                    for (int mt = 0; mt < 2; ++mt) af[mt] = *(const bf16x8*)(wa + (size_t)(wr32 + mt * 16 + fr) * 128 + ks * 32 + fq * 8);
#pragma unroll
                    for (int nt = 0; nt < 4; ++nt) bfr[nt] = *(const bf16x8*)(tileL + (wc64 + nt * 16 + fr) * LDT + ks * 32 + fq * 8);
#pragma unroll
                    for (int mt = 0; mt < 2; ++mt)
#pragma unroll
                        for (int nt = 0; nt < 4; ++nt) acc[mt][nt] = __builtin_amdgcn_mfma_f32_16x16x32_bf16(bfr[nt], af[mt], acc[mt][nt], 0, 0, 0);
                }
#pragma unroll
                for (int mt = 0; mt < 2; ++mt) {
                    const int r = wr32 + mt * 16 + fr, m = mbase + r;
                    const float bsp = a.in[8][(size_t)(l * 6 + h) * 128 + r];
#pragma unroll
                    for (int nt = 0; nt < 4; ++nt) {
                        const int e = h * 128 + wc64 + nt * 16 + fq * 4;
                        float u[4], z[4]; ld4(PROJ + (size_t)m * NIN + C_U + e, u); ld4(PROJ + (size_t)m * NIN + C_ZA + e, z);
                        u32x2 o; o.x = pk2(u[0] * (acc[mt][nt][0] + bsp) * silu(z[0]), u[1] * (acc[mt][nt][1] + bsp) * silu(z[1]));
                        o.y = pk2(u[2] * (acc[mt][nt][2] + bsp) * silu(z[2]), u[3] * (acc[mt][nt][3] + bsp) * silu(z[3]));
                        *(u32x2*)(MIX + (size_t)m * EM + e) = o;
                    }
                }
            } else {
                for (int it = 0; it < 4; ++it) {
                    const int r = r0 + 32 * it, m = mbase + r, ms = m - TP, t = ms & 7, b = ms >> 3;
                    float S[8], vn[8], v[8];
#pragma unroll
                    for (int i = 0; i < 8; ++i) { S[i] = 0.f; vn[i] = 0.f; }
                    const float* wrow = a.in[7] + (size_t)((l * 6 + h) * 128 + t) * 128;
                    for (int s = 0; s <= t; ++s) {
                        ld8(PROJ + (size_t)(m - t + s) * NIN + C_V + c, v);
                        const float rs = rsS[r - t + s], ws = wrow[s];
#pragma unroll
                        for (int i = 0; i < 8; ++i) { vn[i] = v[i] * rs * gv[i]; S[i] += ws * vn[i]; }
                    }
                    const float bsp = a.in[8][(size_t)(l * 6 + h) * 128 + t];
                    float u[8], z[8], o[8];
                    ld8(PROJ + (size_t)m * NIN + C_U + c, u); ld8(PROJ + (size_t)m * NIN + C_ZA + c, z);
#pragma unroll
                    for (int i = 0; i < 8; ++i) o[i] = u[i] * (S[i] + bsp) * silu(z[i]);
                    *(u32x4*)(MIX + (size_t)m * EM + c) = pk8(o);
                    st8f(out + O_NSV + (size_t)((l * 128 + b) * 8 + t) * WA + c, vn);
                }
            }
        }
    }
}

__global__ void __launch_bounds__(512, 2) fwd_kernel(Args a) {
    extern __shared__ __attribute__((aligned(16))) unsigned char lds[];
    cg::grid_group grid = cg::this_grid();
    const int tid = threadIdx.x, lane = tid & 63, wave = __builtin_amdgcn_readfirstlane(tid >> 6);
    const int G = gridDim.x;
    const int gw = blockIdx.x * 8 + wave, NGW = G * 8;
    const int lo = a.ph_lo, hi = a.ph_hi;
    unsigned char* ws = a.ws;
    bf16_t* W1T = (bf16_t*)(ws + WS_W1T); bf16_t* W2T = (bf16_t*)(ws + WS_W2T); bf16_t* WPG = (bf16_t*)(ws + WS_WPG); bf16_t* WSM = (bf16_t*)(ws + WS_WSM);
    bf16_t* H = (bf16_t*)(ws + WS_H); bf16_t* MIX = (bf16_t*)(ws + WS_MIX); bf16_t* PROJ = (bf16_t*)(ws + WS_PROJ); float* OUT = (float*)(ws + WS_OUT);
    float* VSS = (float*)(ws + WS_VSS);
    float* Y = a.out + O_Y;
#define RUN(k) (lo <= (k) && (k) < hi)
#define SEAM(k) do { if (RUN(k) && RUN((k) + 1)) grid.sync(); } while (0)

    if (RUN(0)) {
        LAS float* scr = (LAS float*)((LAS unsigned char*)lds + wave * 16384);
        constexpr int I1 = 16 * 200, I2 = 32 * 32, IP = 2 * 4;
        constexpr int NITEMS = 4 * I1 + 4 * I2 + 16 * IP;
        for (int it = gw; it < NITEMS; it += NGW) {
            int r = it;
            if (r < 4 * I1) { const int l = r / I1; p0_transpose_item(a.in[5] + (size_t)l * D * NIN, D, NIN, W1T + (size_t)l * NIN * D, scr, r % I1, lane); continue; } r -= 4 * I1;
            if (r < 4 * I2) { const int l = r / I2; p0_transpose_item(a.in[12] + (size_t)l * EM * D, EM, D, W2T + (size_t)l * D * EM, scr, r % I2, lane); continue; } r -= 4 * I2;
            { const int mi = r / IP; p0_transpose_item(a.in[9] + (size_t)mi * 128 * 128, 128, 128, WPG + (size_t)mi * 128 * 128, scr, r % IP, lane); }
        }
        for (int idx = blockIdx.x * 512 + tid; idx < 4 * 6 * 128 * 16; idx += G * 512) {
            const int s0 = (idx & 15) * 8, t = (idx >> 4) & 127;
            float v[8]; ld8f(a.in[7] + (size_t)idx * 8, v);
#pragma unroll
            for (int i = 0; i < 8; ++i) if (s0 + i > t) v[i] = 0.f;
            *(u32x4*)(WSM + (size_t)idx * 8) = pk8(v);
        }
        for (int m = gw; m < T; m += NGW) {
            const float* xr = m < TP ? a.in[0] + (size_t)m * D : a.in[1] + (size_t)(m - TP) * D;
            row_norm(xr, nullptr, nullptr, nullptr, a.in[4], H + (size_t)m * D, lane);
        }
    }
    SEAM(0);
    for (int l = 0; l < DEPTH; ++l) {
        const int pb = 1 + 4 * l;
        if (RUN(pb)) {
            pg8::Gemm g{H, W1T + (size_t)l * NIN * D, T, NIN, D}; pg8::StaticOrder S; S.init(T, NIN, G, (int)blockIdx.x);
            pg8::EpiProj E{PROJ, VSS};
            pg8::gemm_phase<pg8::EpiProj, pg8::StaticOrder, true, true>((LAS unsigned char*)lds, g, S, E);
        }
        SEAM(pb);
        if (RUN(pb + 1)) mix_phase(a, l, lds);
        SEAM(pb + 1);
        if (RUN(pb + 2)) {
            pg8::Gemm g{MIX, W2T + (size_t)l * D * EM, T, D, EM}; pg8::StaticOrder S; S.init(T, D, G, (int)blockIdx.x);
            pg8::EpiOutF32 E{OUT};
            pg8::gemm_phase<pg8::EpiOutF32, pg8::StaticOrder, true, true>((LAS unsigned char*)lds, g, S, E);
        }
        SEAM(pb + 2);
        if (RUN(pb + 3)) {
            for (int m = gw; m < T; m += NGW) {
                const float* xr = (l == 0) ? (m < TP ? a.in[0] + (size_t)m * D : a.in[1] + (size_t)(m - TP) * D) : Y + (size_t)m * D;
                row_norm(xr, OUT + (size_t)m * D, a.in[13] + (size_t)l * D, Y + (size_t)m * D,
                         a.in[4] + (size_t)(l + 1 < DEPTH ? l + 1 : 0) * D, (l + 1 < DEPTH) ? H + (size_t)m * D : nullptr, lane);
            }
        }
        SEAM(pb + 3);
    }
#undef RUN
#undef SEAM
}

#ifndef N_LAUNCH_SPLIT
#define N_LAUNCH_SPLIT 0
#endif

extern "C" void kernel_launch(void* const* d_in, const int* in_sizes, int n_in, void* d_out, int out_size, void* d_ws, size_t ws_size, hipStream_t stream) {
    static int grid = 0;
    if (grid == 0) {
        if (n_in != 14 || (size_t)out_size != O_END || ws_size < WS_END) { fprintf(stderr, "kernel_launch: unexpected sizes n_in %d out %d ws %zu (need %zu)\n", n_in, out_size, ws_size, (size_t)WS_END); grid = -1; return; }
        int dev = 0, cus = 0, per_cu = 0;
        hipGetDevice(&dev); hipDeviceGetAttribute(&cus, hipDeviceAttributeMultiprocessorCount, dev);
        if (hipFuncSetAttribute((const void*)fwd_kernel, hipFuncAttributeMaxDynamicSharedMemorySize, LDS_BYTES) != hipSuccess) { fprintf(stderr, "kernel_launch: hipFuncSetAttribute failed\n"); grid = -1; return; }
        if (hipOccupancyMaxActiveBlocksPerMultiprocessor(&per_cu, (const void*)fwd_kernel, 512, LDS_BYTES) != hipSuccess || per_cu < 1) { fprintf(stderr, "kernel_launch: occupancy query says %d\n", per_cu); per_cu = 1; }
        (void)hipGetLastError();
        grid = cus;
    }
    if (grid < 0) return;
    Args a{};
    for (int i = 0; i < 14; ++i) a.in[i] = (const float*)d_in[i];
    a.out = (float*)d_out; a.ws = (unsigned char*)d_ws;
#if N_LAUNCH_SPLIT
    for (int p = 0; p < NPHASE; ++p) { a.ph_lo = p; a.ph_hi = p + 1; hipLaunchKernelGGL(fwd_kernel, dim3(grid), dim3(512), LDS_BYTES, stream, a); }
#else
    a.ph_lo = 0; a.ph_hi = NPHASE;
    void* args[] = {&a};
    hipError_t e = hipLaunchCooperativeKernel((const void*)fwd_kernel, dim3(grid), dim3(512), args, LDS_BYTES, stream);
    if (e != hipSuccess) fprintf(stderr, "cooperative launch failed: %s (grid %d)\n", hipGetErrorString(e), grid);
#endif
}
```

```cpp
#include <hip/hip_runtime.h>
#include <hip/hip_cooperative_groups.h>
#include <cstdio>
#include <cstdint>
namespace cg = cooperative_groups;

#define LAS __attribute__((address_space(3)))
typedef unsigned short bf16_t;
typedef short bf16x8 __attribute__((ext_vector_type(8)));
typedef float f32x4 __attribute__((ext_vector_type(4)));
typedef unsigned u32x4 __attribute__((ext_vector_type(4)));
typedef unsigned u32x2 __attribute__((ext_vector_type(2)));

constexpr int TP = 16384, TS = 1024, T = TP + TS, D = 1024, NIN = 6400, EM = 2048, DEPTH = 4;
constexpr int WA = 768, WB = 512, WC = 768;
constexpr int C_U = 0, C_V = 768, C_ZA = 1536, C_P = 2304, C_ZB = 2816, C_XC = 3328, C_BG = 4096, C_CG = 4864, C_ZC = 5632;
constexpr float EPS = 1e-6f;
constexpr size_t O_Y = 0, O_NSPP = (size_t)T * D, O_NSCP = O_NSPP + 4 * 8 * 15 * 512, O_NSPS = O_NSCP + 4 * 8 * 2 * 768,
                 O_NSCS = O_NSPS + 4 * 128 * 15 * 512, O_NSV = O_NSCS + 4 * 128 * 2 * 768, O_END = O_NSV + 4 * 128 * 8 * 768;
constexpr size_t MiB = 1u << 20;
constexpr size_t WS_CTL = 0, WS_W1T = 1 * MiB, WS_W2T = 51 * MiB, WS_WPG = 67 * MiB, WS_WSM = 67 * MiB + 512 * 1024, WS_VSS = 69 * MiB,
                 WS_H = 70 * MiB, WS_MIX = 104 * MiB, WS_PROJ = 172 * MiB, WS_OUT = WS_PROJ, WS_END = WS_PROJ + (size_t)T * NIN * 2;
constexpr int LDS_BYTES = 131072 + 4096;
constexpr int NPHASE = 1 + 4 * DEPTH;

namespace pg8 {
constexpr int BM = 256, BK = 64, HALF = 128, HTB = HALF * BK * 2, STAGE_BYTES = 8 * HTB, NXCD = 8, WGM = 8;
__host__ __device__ __forceinline__ int lds_byte(int r, int c) { const int st = (r >> 4) * 2 + (c >> 5), rr = r & 15, cc = c & 31, ob = rr * 64 + cc * 2; return st * 1024 + (ob ^ (((ob >> 9) & 1) << 5)); }
__host__ __device__ __forceinline__ void stage_rc(int b, int& R, int& C) { const int st = b / 1024, sb = b % 1024, swz = sb ^ (((sb >> 9) & 1) << 5); R = (st >> 1) * 16 + swz / 64; C = (st & 1) * 32 + (swz % 64) / 2; }
__host__ __device__ __forceinline__ int perm32(int rho) { const int n = rho >> 4, i = rho & 15; return 8 * (i >> 2) + 4 * n + (i & 3); }
struct Unit { int pm, pn; };
struct Gemm { const bf16_t* A; const bf16_t* Bt; int M, N, K; };
struct StaticOrder {
    int nM, nN, nwg, G, c;
    __host__ __device__ void init(int M, int N, int G_, int c_) { nM = M / BM; nN = N / BM; nwg = nM * nN; G = G_; c = c_; }
    __host__ __device__ bool next(int i, Unit& u) const {
        const long L = (long)i * G + c; if (L >= nwg) return false;
        int wgid = (int)L; { const int q = nwg / NXCD, r = nwg % NXCD, xcd = wgid % NXCD, off = wgid / NXCD; wgid = (xcd < r ? xcd * (q + 1) : r * (q + 1) + (xcd - r) * q) + off; }
        const int nig = WGM * nN, gid = wgid / nig, fm = gid * WGM, gsz = (nM - fm) < WGM ? (nM - fm) : WGM;
        u.pm = fm + ((wgid % nig) % gsz); u.pn = (wgid % nig) / gsz; return true;
    }
    __device__ __forceinline__ void a_ready(const Unit&) const {}
    __device__ __forceinline__ void done(const Unit&) const {}
};
__device__ __forceinline__ unsigned cvt_pk_bf16(float lo, float hi) { unsigned r; asm volatile("v_cvt_pk_bf16_f32 %0, %1, %2" : "=v"(r) : "v"(lo), "v"(hi)); return r; }

struct EpiProj {
    static constexpr bool PERM = true, AFTER_DRAIN = false;
    bf16_t* O; float* vss;
    __device__ __forceinline__ void operator()(const f32x4 (&acc)[2][2][4][2], const Unit& u, int wr, int wc, int fr, int fq) const {
        const int row0 = u.pm * BM + wr * 64 + fr; const int col0 = u.pn * BM + wc * 32 + 8 * fq;
#pragma unroll
        for (int ai = 0; ai < 2; ++ai)
#pragma unroll
            for (int m = 0; m < 4; ++m) { bf16_t* rowp = O + (size_t)(row0 + ai * HALF + m * 16) * NIN + col0;
#pragma unroll
                for (int bj = 0; bj < 2; ++bj) { const f32x4 v0 = acc[ai][bj][m][0], v1 = acc[ai][bj][m][1];
                    u32x4 w; w.x = cvt_pk_bf16(v0[0], v0[1]); w.y = cvt_pk_bf16(v0[2], v0[3]); w.z = cvt_pk_bf16(v1[0], v1[1]); w.w = cvt_pk_bf16(v1[2], v1[3]);
                    *(u32x4*)(rowp + bj * HALF) = w; } }
        if (u.pn >= 3 && u.pn < 6) {
            float* dst = vss + (size_t)((u.pn - 3) * 4 + wc) * T;
#pragma unroll
            for (int ai = 0; ai < 2; ++ai)
#pragma unroll
                for (int m = 0; m < 4; ++m) { float s = 0.f;
#pragma unroll
                    for (int bj = 0; bj < 2; ++bj)
#pragma unroll
                        for (int n = 0; n < 2; ++n) { const f32x4 x = acc[ai][bj][m][n]; s += (x[0] * x[0] + x[1] * x[1]) + (x[2] * x[2] + x[3] * x[3]); }
                    s += __shfl_xor(s, 16); s += __shfl_xor(s, 32);
                    if (fq == 0) dst[row0 + ai * HALF + m * 16] = s; }
        }
    }
};
struct EpiOutF32 {
    static constexpr bool PERM = false, AFTER_DRAIN = false;
    float* O;
    __device__ __forceinline__ void operator()(const f32x4 (&acc)[2][2][4][2], const Unit& u, int wr, int wc, int fr, int fq) const {
        const int row0 = u.pm * BM + wr * 64 + fr; const int col0 = u.pn * BM + wc * 32 + 4 * fq;
#pragma unroll
        for (int ai = 0; ai < 2; ++ai)
#pragma unroll
            for (int m = 0; m < 4; ++m) { float* rowp = O + (size_t)(row0 + ai * HALF + m * 16) * D + col0;
#pragma unroll
                for (int bj = 0; bj < 2; ++bj)
#pragma unroll
                    for (int n = 0; n < 2; ++n) *(f32x4*)(rowp + bj * HALF + n * 16) = acc[ai][bj][m][n]; }
    }
};

template <class Epi, class Sched, bool ALIGN_EPI = false, bool SP2 = false>
__device__ __forceinline__ void gemm_phase(LAS unsigned char* lds, const Gemm g, const Sched& S, const Epi& E) {
    int tid_ = threadIdx.x; asm volatile("" : "+v"(tid_));
    const int tid = tid_, wid = __builtin_amdgcn_readfirstlane(tid >> 6), lane = tid & 63, wr = wid >> 2, wc = wid & 3, fr = lane & 15, fq = lane >> 4;
    const int K = g.K, nt = K / BK;
    unsigned voffA[2], voffB[2];
#pragma unroll
    for (int i = 0; i < 2; ++i) { int R, C; stage_rc(tid * 16 + i * 8192, R, C); const int Rb = Epi::PERM ? ((R & ~31) + perm32(R & 31)) : R;
        voffA[i] = (unsigned)(R * K + C) * 2u; voffB[i] = (unsigned)(Rb * K + C) * 2u; }
    const size_t kstep = (size_t)(BK * 2);
    const size_t hstep = (size_t)HALF * K * 2;
    const size_t tstep = 2 * hstep;
    const unsigned ldsw = (unsigned)wid * 1024u;
    const int aoff = lds_byte(wr * 64 + fr, fq * 8), boff = lds_byte(wc * 32 + fr, fq * 8);
#define PG8_SA(b, h) (((b) * 2 + (h)) * HTB)
#define PG8_SB(b, h) ((4 + (b) * 2 + (h)) * HTB)
#define PG8_STAGE(bufoff, gbase, voff) do { _Pragma("unroll") for (int _i = 0; _i < 2; ++_i) \
        __builtin_amdgcn_global_load_lds((const unsigned*)((const char*)(gbase) + (voff)[_i]), (LAS unsigned*)(lds + (bufoff) + ldsw + _i * 8192), 16, 0, 0); } while (0)
#define PG8_LDA(dst, b, h) do { _Pragma("unroll") for (int m = 0; m < 4; ++m) _Pragma("unroll") for (int k = 0; k < 2; ++k) dst[m][k] = *(const LAS bf16x8*)(lds + PG8_SA(b, h) + aoff + m * 2048 + k * 1024); } while (0)
#define PG8_LDB(dst, b, h) do { _Pragma("unroll") for (int n = 0; n < 2; ++n) _Pragma("unroll") for (int k = 0; k < 2; ++k) dst[n][k] = *(const LAS bf16x8*)(lds + PG8_SB(b, h) + boff + n * 2048 + k * 1024); } while (0)
#define PG8_MMA(ai, bj, At, Bt) do { __builtin_amdgcn_s_setprio(1); _Pragma("unroll") for (int m = 0; m < 4; ++m) _Pragma("unroll") for (int n = 0; n < 2; ++n) _Pragma("unroll") for (int k = 0; k < 2; ++k) \
        acc[ai][bj][m][n] = __builtin_amdgcn_mfma_f32_16x16x32_bf16(Bt[n][k], At[m][k], acc[ai][bj][m][n], 0, 0, 0); __builtin_amdgcn_s_setprio(0); } while (0)
#define PG8_WAIT_V(n) asm volatile("s_waitcnt vmcnt(" #n ")" ::: "memory")
#define PG8_WAIT_L(n) asm volatile("s_waitcnt lgkmcnt(" #n ")" ::: "memory")
#define PG8_BAR __builtin_amdgcn_s_barrier()
#define PG8_SCHED __builtin_amdgcn_sched_barrier(0)
    Unit cur, nxt; int ui = 0;
    if (!S.next(0, cur)) return;
    f32x4 acc[2][2][4][2];
#pragma unroll
    for (int a = 0; a < 2; ++a)
#pragma unroll
        for (int b = 0; b < 2; ++b)
#pragma unroll
            for (int m = 0; m < 4; ++m)
#pragma unroll
                for (int n = 0; n < 2; ++n) acc[a][b][m][n] = (f32x4){0.f, 0.f, 0.f, 0.f};
    bf16x8 At[4][2], B0[2][2], B1[2][2];
    const char* cA = (const char*)g.A + (size_t)cur.pm * tstep; const char* cB = (const char*)g.Bt + (size_t)cur.pn * tstep;
    S.a_ready(cur);
    if constexpr (SP2) {
        PG8_STAGE(PG8_SB(0, 0), cB, voffB); PG8_STAGE(PG8_SB(0, 1), cB + hstep, voffB); PG8_STAGE(PG8_SA(0, 0), cA, voffA); PG8_STAGE(PG8_SA(0, 1), cA + hstep, voffA);
        if (wr == 1) PG8_BAR;
        PG8_WAIT_V(2); PG8_BAR;
        PG8_STAGE(PG8_SB(1, 0), cB + kstep, voffB); PG8_STAGE(PG8_SA(1, 0), cA + kstep, voffA); PG8_STAGE(PG8_SB(1, 1), cB + hstep + kstep, voffB);
        PG8_WAIT_V(6); PG8_BAR;
    } else {
        PG8_STAGE(PG8_SB(0, 0), cB, voffB); PG8_STAGE(PG8_SA(0, 0), cA, voffA); PG8_STAGE(PG8_SB(0, 1), cB + hstep, voffB); PG8_STAGE(PG8_SA(0, 1), cA + hstep, voffA);
        if (wr == 1) PG8_BAR;
        PG8_WAIT_V(4); PG8_BAR;
        PG8_STAGE(PG8_SB(1, 0), cB + kstep, voffB); PG8_STAGE(PG8_SA(1, 0), cA + kstep, voffA); PG8_STAGE(PG8_SB(1, 1), cB + hstep + kstep, voffB);
        PG8_WAIT_V(6); PG8_BAR;
    }
    for (;;) {
        const bool has_next = S.next(ui + 1, nxt);
        const char* nA = has_next ? (const char*)g.A + (size_t)nxt.pm * tstep : cA; const char* nB = has_next ? (const char*)g.Bt + (size_t)nxt.pn * tstep : cB;
        for (int t = 0; t < nt; t += 2) {
            const bool last = (t == nt - 2);
            const char* a1 = cA + (size_t)(t + 1) * kstep;
            const char* a2 = last ? nA : cA + (size_t)(t + 2) * kstep; const char* b2 = last ? nB : cB + (size_t)(t + 2) * kstep;
            const char* a3 = a2 + kstep; const char* b3 = b2 + kstep;
            if (last && has_next) S.a_ready(nxt);
            if constexpr (SP2) {
            PG8_LDB(B0, 0, 0); PG8_LDB(B1, 0, 1); PG8_SCHED; PG8_LDA(At, 0, 0); PG8_STAGE(PG8_SA(1, 1), a1 + hstep, voffA);
            PG8_WAIT_V(8); PG8_WAIT_L(0); PG8_BAR; PG8_MMA(0, 0, At, B0); PG8_MMA(0, 1, At, B1); PG8_BAR; PG8_SCHED;
            PG8_LDA(At, 0, 1); PG8_STAGE(PG8_SB(0, 0), b2, voffB); PG8_STAGE(PG8_SB(0, 1), b2 + hstep, voffB); PG8_STAGE(PG8_SA(0, 0), a2, voffA);
            PG8_WAIT_V(8); PG8_WAIT_L(0); PG8_BAR; PG8_MMA(1, 0, At, B0); PG8_MMA(1, 1, At, B1); PG8_BAR; PG8_SCHED;
            PG8_LDB(B0, 1, 0); PG8_LDB(B1, 1, 1); PG8_SCHED; PG8_LDA(At, 1, 0); PG8_STAGE(PG8_SA(0, 1), a2 + hstep, voffA);
            PG8_WAIT_V(8); PG8_WAIT_L(0); PG8_BAR; PG8_MMA(0, 0, At, B0); PG8_MMA(0, 1, At, B1); PG8_BAR; PG8_SCHED;
            PG8_LDA(At, 1, 1); PG8_STAGE(PG8_SB(1, 0), b3, voffB); PG8_STAGE(PG8_SB(1, 1), b3 + hstep, voffB); PG8_STAGE(PG8_SA(1, 0), a3, voffA);
            PG8_WAIT_V(8); PG8_WAIT_L(0); PG8_BAR; PG8_MMA(1, 0, At, B0); PG8_MMA(1, 1, At, B1); PG8_BAR; PG8_SCHED;
            } else {
            PG8_LDB(B0, 0, 0); PG8_SCHED; PG8_LDA(At, 0, 0); PG8_STAGE(PG8_SA(1, 1), a1 + hstep, voffA);
            PG8_WAIT_L(8); PG8_BAR; PG8_WAIT_L(0); PG8_MMA(0, 0, At, B0); PG8_BAR; PG8_SCHED;
            PG8_LDB(B1, 0, 1); PG8_STAGE(PG8_SB(0, 0), b2, voffB);
            PG8_BAR; PG8_WAIT_L(0); PG8_MMA(0, 1, At, B1); PG8_BAR;
            PG8_LDA(At, 0, 1); PG8_STAGE(PG8_SA(0, 0), a2, voffA);
            PG8_BAR; PG8_WAIT_L(0); PG8_MMA(1, 0, At, B0); PG8_BAR; PG8_SCHED;
            PG8_STAGE(PG8_SB(0, 1), b2 + hstep, voffB);
            PG8_WAIT_V(6); PG8_BAR; PG8_MMA(1, 1, At, B1); PG8_BAR;
            PG8_LDB(B0, 1, 0); PG8_SCHED; PG8_LDA(At, 1, 0); PG8_STAGE(PG8_SA(0, 1), a2 + hstep, voffA);
            PG8_WAIT_L(8); PG8_BAR; PG8_WAIT_L(0); PG8_MMA(0, 0, At, B0); PG8_BAR; PG8_SCHED;
            PG8_LDB(B1, 1, 1); PG8_STAGE(PG8_SB(1, 0), b3, voffB);
            PG8_BAR; PG8_WAIT_L(0); PG8_MMA(0, 1, At, B1); PG8_BAR;
            PG8_LDA(At, 1, 1); PG8_STAGE(PG8_SA(1, 0), a3, voffA);
            PG8_BAR; PG8_WAIT_L(0); PG8_MMA(1, 0, At, B0); PG8_BAR; PG8_SCHED;
            PG8_STAGE(PG8_SB(1, 1), b3 + hstep, voffB);
            PG8_WAIT_V(6); PG8_BAR; PG8_MMA(1, 1, At, B1); PG8_BAR;
            }
        }
        if constexpr (ALIGN_EPI) { if (wr == 0) PG8_BAR; }
        if constexpr (!Epi::AFTER_DRAIN) { E(acc, cur, wr, wc, fr, fq); S.done(cur); }
        if (!has_next) break;
#pragma unroll
        for (int a = 0; a < 2; ++a)
#pragma unroll
            for (int b = 0; b < 2; ++b)
#pragma unroll
                for (int m = 0; m < 4; ++m)
#pragma unroll
                    for (int n = 0; n < 2; ++n) acc[a][b][m][n] = (f32x4){0.f, 0.f, 0.f, 0.f};
        cur = nxt; cA = nA; cB = nB; ++ui;
        if constexpr (ALIGN_EPI) { if (wr == 1) PG8_BAR; }
    }
    PG8_WAIT_V(0);
    if constexpr (!ALIGN_EPI) { if (wr == 0) PG8_BAR; }
    PG8_BAR;
#undef PG8_SA
#undef PG8_SB
#undef PG8_STAGE
#undef PG8_LDA
#undef PG8_LDB
#undef PG8_MMA
#undef PG8_WAIT_V
#undef PG8_WAIT_L
#undef PG8_BAR
#undef PG8_SCHED
}
}

#define LDS_WAIT() asm volatile("s_waitcnt lgkmcnt(0)" ::: "memory")
__device__ __forceinline__ unsigned f2bf(float f) { unsigned u = __builtin_bit_cast(unsigned, f); return (u + 0x7fffu + ((u >> 16) & 1u)) >> 16; }
__device__ __forceinline__ unsigned pk2(float lo, float hi) { return f2bf(lo) | (f2bf(hi) << 16); }
__device__ __forceinline__ float wave_sum(float v) {
#pragma unroll
    for (int o = 1; o < 64; o <<= 1) v += __shfl_xor(v, o);
    return v;
}
__device__ __forceinline__ float silu(float x) { return x / (1.f + __expf(-x)); }
__device__ __forceinline__ void ld8(const bf16_t* p, float (&f)[8]) {
    const u32x4 w = *(const u32x4*)p;
    f[0] = __uint_as_float(w.x << 16); f[1] = __uint_as_float(w.x & 0xffff0000u); f[2] = __uint_as_float(w.y << 16); f[3] = __uint_as_float(w.y & 0xffff0000u);
    f[4] = __uint_as_float(w.z << 16); f[5] = __uint_as_float(w.z & 0xffff0000u); f[6] = __uint_as_float(w.w << 16); f[7] = __uint_as_float(w.w & 0xffff0000u);
}
__device__ __forceinline__ void ld4(const bf16_t* p, float (&f)[4]) {
    const u32x2 w = *(const u32x2*)p;
    f[0] = __uint_as_float(w.x << 16); f[1] = __uint_as_float(w.x & 0xffff0000u); f[2] = __uint_as_float(w.y << 16); f[3] = __uint_as_float(w.y & 0xffff0000u);
}
__device__ __forceinline__ void ld8f(const float* p, float (&f)[8]) {
    const f32x4 a = *(const f32x4*)p, b = *(const f32x4*)(p + 4);
    f[0] = a[0]; f[1] = a[1]; f[2] = a[2]; f[3] = a[3]; f[4] = b[0]; f[5] = b[1]; f[6] = b[2]; f[7] = b[3];
}
__device__ __forceinline__ void st8f(float* p, const float (&f)[8]) {
    *(f32x4*)p = (f32x4){f[0], f[1], f[2], f[3]}; *(f32x4*)(p + 4) = (f32x4){f[4], f[5], f[6], f[7]};
}
__device__ __forceinline__ u32x4 pk8(const float (&f)[8]) {
    u32x4 w; w.x = pk2(f[0], f[1]); w.y = pk2(f[2], f[3]); w.z = pk2(f[4], f[5]); w.w = pk2(f[6], f[7]); return w;
}

#define XB_TMO      128
#define XB_XCNT(j)  (256  + 64 * (j))
#define XB_XSUB(j)  (1280 + 64 * (j))
#define XB_XGEN(j)  (2304 + 64 * (j))
#define XB_TOP      3328
#define XB_TOPGEN   3392
#define XCD_BAR_WORDS 3456
#define XB_SPIN_CAP (1u << 22)
__device__ __forceinline__ unsigned xb_ld(unsigned* p)              { return __hip_atomic_load(p, __ATOMIC_RELAXED, __HIP_MEMORY_SCOPE_AGENT); }
__device__ __forceinline__ unsigned xb_add(unsigned* p, unsigned v) { return __hip_atomic_fetch_add(p, v, __ATOMIC_RELAXED, __HIP_MEMORY_SCOPE_AGENT); }
__device__ __forceinline__ unsigned xb_xcc_id() { return (unsigned)__builtin_amdgcn_s_getreg((3 << 11) | 20) & 0xFu; }
#define XB_SPIN(cond, bar) do { unsigned _sp = 0; while (cond) { __builtin_amdgcn_s_sleep(1); \
    if ((++_sp & 255u) == 0u) { if (xb_ld(&(bar)[XB_TMO])) break; if (_sp > XB_SPIN_CAP) { atomicAdd(&(bar)[XB_TMO], 1u); break; } } } } while (0)
struct XcdBarrier { unsigned* bar; unsigned x; volatile LAS unsigned* st; };
__device__ __forceinline__ XcdBarrier xcd_barrier_post(unsigned* bar, volatile LAS unsigned* st) {
    XcdBarrier b; b.bar = bar; b.x = xb_xcc_id(); b.st = st;
    if (threadIdx.x == 0) (void)xb_add(&bar[XB_XCNT(b.x)], 1u);
    return b;
}
__device__ __forceinline__ void xcd_barrier_complete(unsigned* bar, unsigned x, unsigned& nloc, unsigned& nx) {
    const unsigned G = gridDim.x * gridDim.y * gridDim.z;
    unsigned sum, cnt, mine, sp = 0u;
    for (;;) {
        sum = 0u; cnt = 0u; mine = 0u;
#pragma unroll
        for (unsigned j = 0; j < 16; ++j) { const unsigned c = xb_ld(&bar[XB_XCNT(j)]); sum += c; cnt += (c > 0u) ? 1u : 0u; mine = (j == x) ? c : mine; }
        if (sum == G) break;
        __builtin_amdgcn_s_sleep(1);
        if ((++sp & 255u) == 0u) { if (xb_ld(&bar[XB_TMO])) break; if (sp > XB_SPIN_CAP) { atomicAdd(&bar[XB_TMO], 1u); break; } }
    }
    nloc = mine > 0u ? mine : 1u; nx = cnt > 0u ? cnt : 1u;
}
__device__ __forceinline__ void xcd_barrier(const XcdBarrier& b) {
    asm volatile("s_waitcnt vmcnt(0)" ::: "memory");
    __syncthreads();
    if (threadIdx.x == 0) {
        unsigned* bar = b.bar;
        __builtin_amdgcn_s_waitcnt(0);
        unsigned nloc = b.st[0], nx = b.st[1];
        if (nloc == 0u) { xcd_barrier_complete(bar, b.x, nloc, nx); b.st[0] = nloc; b.st[1] = nx; }
        const unsigned old = xb_add(&bar[XB_XSUB(b.x)], 1u);
        const unsigned gen = old / nloc;
        if (old + 1u == (gen + 1u) * nloc) {
            __builtin_amdgcn_fence(__ATOMIC_RELEASE, "agent");
            asm volatile("s_waitcnt vmcnt(0)" ::: "memory");
            const unsigned og = xb_add(&bar[XB_TOP], 1u);
            const unsigned tg = og / nx;
            if (og + 1u == (tg + 1u) * nx) xb_add(&bar[XB_TOPGEN], 1u);
            else XB_SPIN(xb_ld(&bar[XB_TOPGEN]) == tg, bar);
            __builtin_amdgcn_fence(__ATOMIC_ACQUIRE, "agent");
            xb_add(&bar[XB_XGEN(b.x)], 1u);
            asm volatile("s_waitcnt vmcnt(0)" ::: "memory");
        } else {
            XB_SPIN(xb_ld(&bar[XB_XGEN(b.x)]) == gen, bar);
            __builtin_amdgcn_fence(__ATOMIC_ACQUIRE, "agent");
            asm volatile("s_waitcnt vmcnt(0)" ::: "memory");
        }
    }
    __syncthreads();
}

struct Args { const float* in[14]; float* out; unsigned char* ws; int ph_lo, ph_hi; };

__device__ __forceinline__ void p0_transpose_item(const float* W, int K, int N, bf16_t* WT, LAS float* scr, int item, int lane) {
    const int nblk = N / 32, kb = item / nblk, nb = item % nblk, k0 = 64 * kb, n0 = 32 * nb;
#pragma unroll 8
    for (int i = 0; i < 32; ++i) { const int kk = 2 * i + (lane >> 5); scr[kk * 33 + (lane & 31)] = W[(size_t)(k0 + kk) * N + n0 + (lane & 31)]; }
    LDS_WAIT(); asm volatile("" ::: "memory");
    const int c = lane & 7;
#pragma unroll
    for (int j = 0; j < 4; ++j) { const int n = (lane >> 3) + 8 * j; const LAS float* s = scr + (8 * c) * 33 + n;
        u32x4 o; o.x = pk2(s[0 * 33], s[1 * 33]); o.y = pk2(s[2 * 33], s[3 * 33]); o.z = pk2(s[4 * 33], s[5 * 33]); o.w = pk2(s[6 * 33], s[7 * 33]);
        *(u32x4*)(WT + (size_t)(n0 + n) * K + k0 + 8 * c) = o; }
    LDS_WAIT(); asm volatile("" ::: "memory");
}

__device__ __forceinline__ void row_norm(const float* xrow, const float* orow, const float* gpost, float* yout, const float* gpre, bf16_t* hrow, int lane) {
    f32x4 v[4];
#pragma unroll
    for (int j = 0; j < 4; ++j) v[j] = ((const f32x4*)xrow)[lane + 64 * j];
    if (orow) {
        f32x4 o[4]; float s = 0.f;
#pragma unroll
        for (int j = 0; j < 4; ++j) { o[j] = ((const f32x4*)orow)[lane + 64 * j]; s += (o[j][0] * o[j][0] + o[j][1] * o[j][1]) + (o[j][2] * o[j][2] + o[j][3] * o[j][3]); }
        const float rs = rsqrtf(wave_sum(s) * (1.f / D) + EPS);
#pragma unroll
        for (int j = 0; j < 4; ++j) { const f32x4 g = ((const f32x4*)gpost)[lane + 64 * j]; v[j] = v[j] + o[j] * rs * g; ((f32x4*)yout)[lane + 64 * j] = v[j]; }
    }
    if (hrow) {
        float s = 0.f;
#pragma unroll
        for (int j = 0; j < 4; ++j) s += (v[j][0] * v[j][0] + v[j][1] * v[j][1]) + (v[j][2] * v[j][2] + v[j][3] * v[j][3]);
        const float rs = rsqrtf(wave_sum(s) * (1.f / D) + EPS);
#pragma unroll
        for (int j = 0; j < 4; ++j) { const f32x4 g = ((const f32x4*)gpre)[lane + 64 * j]; const f32x4 h = v[j] * rs * g;
            u32x2 w; w.x = pk2(h[0], h[1]); w.y = pk2(h[2], h[3]); ((u32x2*)hrow)[lane + 64 * j] = w; }
    }
}

constexpr int LDT = 136;
__device__ __forceinline__ void mix_phase(const Args& a, int l, unsigned char* lds) {
    int tid_ = threadIdx.x; asm volatile("" : "+v"(tid_));
    const int tid = tid_, lane = tid & 63, wid = tid >> 6, fr = lane & 15, fq = lane >> 4;
    const int q = tid & 15, r0 = tid >> 4;
    const int wr32 = (wid >> 1) * 32, wc64 = (wid & 1) * 64;
    bf16_t* tileL = (bf16_t*)lds;
    float* rsS = (float*)(lds + 128 * LDT * 2);
    const bf16_t* PROJ = (const bf16_t*)(a.ws + WS_PROJ);
    bf16_t* MIX = (bf16_t*)(a.ws + WS_MIX);
    const float* vss = (const float*)(a.ws + WS_VSS);
    const bf16_t* Wpg = (const bf16_t*)(a.ws + WS_WPG);
    const bf16_t* Wsm = (const bf16_t*)(a.ws + WS_WSM);
    float* out = a.out;
    for (int job = blockIdx.x; job < 136 * 16; job += gridDim.x) {
        const int tile = job >> 4, slice = job & 15;
        const bool isS = tile >= 128;
        const int mbase = tile * 128;
        __syncthreads();
        if (slice >= 10) {
            const int c = (slice - 10) * 128 + q * 8;
            float w0[8], w1[8], w2[8];
            ld8f(a.in[11] + (size_t)(l * 3 + 0) * WC + c, w0); ld8f(a.in[11] + (size_t)(l * 3 + 1) * WC + c, w1); ld8f(a.in[11] + (size_t)(l * 3 + 2) * WC + c, w2);
            for (int it = 0; it < 4; ++it) {
                const int r = r0 + 32 * it, m = mbase + r;
                const bf16_t* pr = PROJ + (size_t)m * NIN;
                float xc[8], cgv[8], cx0[8], cx1[8], cx2[8], bg[8], zc[8];
                ld8(pr + C_XC + c, xc); ld8(pr + C_CG + c, cgv); ld8(pr + C_BG + c, bg); ld8(pr + C_ZC + c, zc);
#pragma unroll
                for (int i = 0; i < 8; ++i) { cx0[i] = cgv[i] * xc[i]; cx1[i] = 0.f; cx2[i] = 0.f; }
                int t, b;
                if (!isS) { t = m & 2047; b = m >> 11; } else { const int ms = m - TP; t = ms & 7; b = ms >> 3; }
                if (t >= 1) { ld8(pr - NIN + C_XC + c, xc); ld8(pr - NIN + C_CG + c, cgv);
#pragma unroll
                    for (int i = 0; i < 8; ++i) cx1[i] = cgv[i] * xc[i]; }
                else if (isS) ld8f(a.in[3] + (size_t)((l * 128 + b) * 2 + 1) * WC + c, cx1);
                if (t >= 2) { ld8(pr - 2 * NIN + C_XC + c, xc); ld8(pr - 2 * NIN + C_CG + c, cgv);
#pragma unroll
                    for (int i = 0; i < 8; ++i) cx2[i] = cgv[i] * xc[i]; }
                else if (isS) ld8f(a.in[3] + (size_t)((l * 128 + b) * 2 + t) * WC + c, cx2);
                float o[8];
#pragma unroll
                for (int i = 0; i < 8; ++i) o[i] = bg[i] * (w0[i] * cx2[i] + w1[i] * cx1[i] + w2[i] * cx0[i]) * silu(zc[i]);
                *(u32x4*)(MIX + (size_t)m * EM + 1280 + c) = pk8(o);
                if (!isS) { if (t >= 2046) st8f(out + O_NSCP + (size_t)((l * 8 + b) * 2 + (t - 2046)) * WC + c, cx0); }
                else { if (t >= 6) st8f(out + O_NSCS + (size_t)((l * 128 + b) * 2 + (t - 6)) * WC + c, cx0); }
            }
        } else if (slice >= 6) {
            const int g = slice - 6, w = 2 << g, c = g * 128 + q * 8;
            for (int it = 0; it < 4; ++it) {
                const int r = r0 + 32 * it, m = mbase + r;
                const bf16_t* pr = PROJ + (size_t)m * NIN + C_P + c;
                float sum[8], pc[8], v[8]; float inv;
                ld8(pr, pc);
#pragma unroll
                for (int i = 0; i < 8; ++i) sum[i] = pc[i];
                if (!isS) {
                    const int t = m & 2047, b = m >> 11; const int n = (t + 1) < w ? (t + 1) : w;
                    for (int i = 1; i < n; ++i) { ld8(pr - (size_t)i * NIN, v);
#pragma unroll
                        for (int k = 0; k < 8; ++k) sum[k] += v[k]; }
                    inv = 1.f / (float)n;
                    if (t >= 2033) st8f(out + O_NSPP + (size_t)((l * 8 + b) * 15 + (t - 2033)) * WB + c, pc);
                } else {
                    const int ms = m - TP, t = ms & 7, b = ms >> 3;
                    for (int i = 1; i < w; ++i) {
                        if (t - i >= 0) ld8(pr - (size_t)i * NIN, v); else ld8f(a.in[2] + (size_t)((l * 128 + b) * 15 + 15 + t - i) * WB + c, v);
#pragma unroll
                        for (int k = 0; k < 8; ++k) sum[k] += v[k]; }
                    inv = 1.f / (float)w;
                    st8f(out + O_NSPS + (size_t)((l * 128 + b) * 15 + 7 + t) * WB + c, pc);
                }
                float d[8];
#pragma unroll
                for (int i = 0; i < 8; ++i) d[i] = sum[i] * inv - pc[i];
                *(u32x4*)(tileL + r * LDT + q * 8) = pk8(d);
            }
            if (isS) {
                for (int idx = tid; idx < 16 * 7 * 16; idx += 512) {
                    const int sq = idx / 112, rem = idx % 112, j = rem >> 4, qq = rem & 15, b = (tile - 128) * 16 + sq;
                    float v[8]; ld8f(a.in[2] + (size_t)((l * 128 + b) * 15 + 8 + j) * WB + g * 128 + qq * 8, v);
                    st8f(out + O_NSPS + (size_t)((l * 128 + b) * 15 + j) * WB + g * 128 + qq * 8, v);
                }
            }
            __syncthreads();
            f32x4 acc[2][4];
#pragma unroll
            for (int mt = 0; mt < 2; ++mt)
#pragma unroll
                for (int nt = 0; nt < 4; ++nt) acc[mt][nt] = (f32x4){0.f, 0.f, 0.f, 0.f};
            const bf16_t* wb = Wpg + (size_t)(l * 4 + g) * 128 * 128;
#pragma unroll
            for (int ks = 0; ks < 4; ++ks) {
                bf16x8 af[2], bfr[4];
#pragma unroll
                for (int mt = 0; mt < 2; ++mt) af[mt] = *(const bf16x8*)(tileL + (wr32 + mt * 16 + fr) * LDT + ks * 32 + fq * 8);
#pragma unroll
                for (int nt = 0; nt < 4; ++nt) bfr[nt] = *(const bf16x8*)(wb + (size_t)(wc64 + nt * 16 + fr) * 128 + ks * 32 + fq * 8);
#pragma unroll
                for (int mt = 0; mt < 2; ++mt)
#pragma unroll
                    for (int nt = 0; nt < 4; ++nt) acc[mt][nt] = __builtin_amdgcn_mfma_f32_16x16x32_bf16(bfr[nt], af[mt], acc[mt][nt], 0, 0, 0);
            }
#pragma unroll
            for (int mt = 0; mt < 2; ++mt) {
                const int m = mbase + wr32 + mt * 16 + fr;
#pragma unroll
                for (int nt = 0; nt < 4; ++nt) {
                    const int e = g * 128 + wc64 + nt * 16 + fq * 4;
                    float z[4]; ld4(PROJ + (size_t)m * NIN + C_ZB + e, z);
                    const f32x4 ps = *(const f32x4*)(a.in[10] + (size_t)l * WB + e);
                    u32x2 o; o.x = pk2(acc[mt][nt][0] * ps[0] * silu(z[0]), acc[mt][nt][1] * ps[1] * silu(z[1]));
                    o.y = pk2(acc[mt][nt][2] * ps[2] * silu(z[2]), acc[mt][nt][3] * ps[3] * silu(z[3]));
                    *(u32x2*)(MIX + (size_t)m * EM + 768 + e) = o;
                }
            }
        } else {
            const int h = slice, c = h * 128 + q * 8;
            if (tid < 128) { const int m = mbase + tid; float s = 0.f;
#pragma unroll
                for (int p = 0; p < 12; ++p) s += vss[(size_t)p * T + m];
                rsS[tid] = rsqrtf(s * (1.f / WA) + EPS); }
            __syncthreads();
            float gv[8]; ld8f(a.in[6] + (size_t)l * WA + c, gv);
            if (!isS) {
                for (int it = 0; it < 4; ++it) {
                    const int r = r0 + 32 * it, m = mbase + r;
                    float v[8]; ld8(PROJ + (size_t)m * NIN + C_V + c, v);
                    const float rs = rsS[r];
#pragma unroll
                    for (int i = 0; i < 8; ++i) tileL[(q * 8 + i) * LDT + r] = (bf16_t)f2bf(v[i] * rs * gv[i]);
                }
                __syncthreads();
                f32x4 acc[2][4];
#pragma unroll
                for (int mt = 0; mt < 2; ++mt)
#pragma unroll
                    for (int nt = 0; nt < 4; ++nt) acc[mt][nt] = (f32x4){0.f, 0.f, 0.f, 0.f};
                const bf16_t* wa = Wsm + (size_t)(l * 6 + h) * 128 * 128;
                const int nks = (wid >> 1) + 1;
                for (int ks = 0; ks < nks; ++ks) {
                    bf16x8 af[2], bfr[4];
#pragma unroll
                    for (int mt = 0; mt < 2; ++mt) af[mt] = *(const bf16x8*)(wa + (size_t)(wr32 + mt * 16 + fr) * 128 + ks * 32 + fq * 8);
#pragma unroll
                    for (int nt = 0; nt < 4; ++nt) bfr[nt] = *(const bf16x8*)(tileL + (wc64 + nt * 16 + fr) * LDT + ks * 32 + fq * 8);
#pragma unroll
                    for (int mt = 0; mt < 2; ++mt)
#pragma unroll
                        for (int nt = 0; nt < 4; ++nt) acc[mt][nt] = __builtin_amdgcn_mfma_f32_16x16x32_bf16(bfr[nt], af[mt], acc[mt][nt], 0, 0, 0);
                }
#pragma unroll
                for (int mt = 0; mt < 2; ++mt) {
                    const int r = wr32 + mt * 16 + fr, m = mbase + r;
                    const float bsp = a.in[8][(size_t)(l * 6 + h) * 128 + r];
#pragma unroll
                    for (int nt = 0; nt < 4; ++nt) {
                        const int e = h * 128 + wc64 + nt * 16 + fq * 4;
                        float u[4], z[4]; ld4(PROJ + (size_t)m * NIN + C_U + e, u); ld4(PROJ + (size_t)m * NIN + C_ZA + e, z);
                        u32x2 o; o.x = pk2(u[0] * (acc[mt][nt][0] + bsp) * silu(z[0]), u[1] * (acc[mt][nt][1] + bsp) * silu(z[1]));
                        o.y = pk2(u[2] * (acc[mt][nt][2] + bsp) * silu(z[2]), u[3] * (acc[mt][nt][3] + bsp) * silu(z[3]));
                        *(u32x2*)(MIX + (size_t)m * EM + e) = o;
                    }
                }
            } else {
                for (int it = 0; it < 4; ++it) {
                    const int r = r0 + 32 * it, m = mbase + r, ms = m - TP, t = ms & 7, b = ms >> 3;
                    float S[8], vn[8], v[8];
#pragma unroll
                    for (int i = 0; i < 8; ++i) { S[i] = 0.f; vn[i] = 0.f; }
                    const float* wrow = a.in[7] + (size_t)((l * 6 + h) * 128 + t) * 128;
                    for (int s = 0; s <= t; ++s) {
                        ld8(PROJ + (size_t)(m - t + s) * NIN + C_V + c, v);
                        const float rs = rsS[r - t + s], ws = wrow[s];
#pragma unroll
                        for (int i = 0; i < 8; ++i) { vn[i] = v[i] * rs * gv[i]; S[i] += ws * vn[i]; }
                    }
                    const float bsp = a.in[8][(size_t)(l * 6 + h) * 128 + t];
                    float u[8], z[8], o[8];
                    ld8(PROJ + (size_t)m * NIN + C_U + c, u); ld8(PROJ + (size_t)m * NIN + C_ZA + c, z);
#pragma unroll
                    for (int i = 0; i < 8; ++i) o[i] = u[i] * (S[i] + bsp) * silu(z[i]);
                    *(u32x4*)(MIX + (size_t)m * EM + c) = pk8(o);
                    st8f(out + O_NSV + (size_t)((l * 128 + b) * 8 + t) * WA + c, vn);
                }
            }
        }
    }
}

__global__ void __launch_bounds__(512, 2) fwd_kernel(Args a) {
    extern __shared__ __attribute__((aligned(16))) unsigned char lds[];
    cg::grid_group grid = cg::this_grid();
    const int tid = threadIdx.x, lane = tid & 63, wave = __builtin_amdgcn_readfirstlane(tid >> 6);
    const int G = gridDim.x;
    const int gw = blockIdx.x * 8 + wave, NGW = G * 8;
    const int lo = a.ph_lo, hi = a.ph_hi;
    unsigned char* ws = a.ws;
    bf16_t* W1T = (bf16_t*)(ws + WS_W1T); bf16_t* W2T = (bf16_t*)(ws + WS_W2T); bf16_t* WPG = (bf16_t*)(ws + WS_WPG); bf16_t* WSM = (bf16_t*)(ws + WS_WSM);
    bf16_t* H = (bf16_t*)(ws + WS_H); bf16_t* MIX = (bf16_t*)(ws + WS_MIX); bf16_t* PROJ = (bf16_t*)(ws + WS_PROJ); float* OUT = (float*)(ws + WS_OUT);
    float* VSS = (float*)(ws + WS_VSS);
    float* Y = a.out + O_Y;
#define RUN(k) (lo <= (k) && (k) < hi)
#define SEAM(k) do { if (RUN(k) && RUN((k) + 1)) { xcd_barrier(bar); if (DUP == 6) xcd_barrier(bar); } } while (0)
    volatile LAS unsigned* misc = (volatile LAS unsigned*)((LAS unsigned char*)lds + 131072 + 2048);
    if (tid < 4) misc[tid] = 0u;
    __syncthreads();
    XcdBarrier bar = xcd_barrier_post((unsigned*)(ws + WS_CTL) + 4096, misc);
    if (lo < 0) grid.sync();

#ifndef DUP
#define DUP 0
#endif
    for (int rep_ = 0; rep_ < (DUP == 5 ? 2 : 1); ++rep_)
    if (RUN(0)) {
        LAS float* scr = (LAS float*)((LAS unsigned char*)lds + wave * 16384);
        constexpr int I1 = 16 * 200, I2 = 32 * 32, IP = 2 * 4;
        constexpr int NITEMS = 4 * I1 + 4 * I2 + 16 * IP;
        for (int it = gw; it < NITEMS; it += NGW) {
            int r = it;
            if (r < 4 * I1) { const int l = r / I1; p0_transpose_item(a.in[5] + (size_t)l * D * NIN, D, NIN, W1T + (size_t)l * NIN * D, scr, r % I1, lane); continue; } r -= 4 * I1;
            if (r < 4 * I2) { const int l = r / I2; p0_transpose_item(a.in[12] + (size_t)l * EM * D, EM, D, W2T + (size_t)l * D * EM, scr, r % I2, lane); continue; } r -= 4 * I2;
            { const int mi = r / IP; p0_transpose_item(a.in[9] + (size_t)mi * 128 * 128, 128, 128, WPG + (size_t)mi * 128 * 128, scr, r % IP, lane); }
        }
        for (int idx = blockIdx.x * 512 + tid; idx < 4 * 6 * 128 * 16; idx += G * 512) {
            const int s0 = (idx & 15) * 8, t = (idx >> 4) & 127;
            float v[8]; ld8f(a.in[7] + (size_t)idx * 8, v);
#pragma unroll
            for (int i = 0; i < 8; ++i) if (s0 + i > t) v[i] = 0.f;
            *(u32x4*)(WSM + (size_t)idx * 8) = pk8(v);
        }
        for (int m = gw; m < T; m += NGW) {
            const float* xr = m < TP ? a.in[0] + (size_t)m * D : a.in[1] + (size_t)(m - TP) * D;
            row_norm(xr, nullptr, nullptr, nullptr, a.in[4], H + (size_t)m * D, lane);
        }
    }
    SEAM(0);
    for (int l = 0; l < DEPTH; ++l) {
        const int pb = 1 + 4 * l;
        for (int rep_ = 0; rep_ < (DUP == 1 ? 2 : 1); ++rep_)
        if (RUN(pb)) {
            pg8::Gemm g{H, W1T + (size_t)l * NIN * D, T, NIN, D}; pg8::StaticOrder S; S.init(T, NIN, G, (int)blockIdx.x);
            pg8::EpiProj E{PROJ, VSS};
            pg8::gemm_phase<pg8::EpiProj, pg8::StaticOrder, true, true>((LAS unsigned char*)lds, g, S, E);
        }
        SEAM(pb);
        for (int rep_ = 0; rep_ < (DUP == 2 ? 2 : 1); ++rep_)
        if (RUN(pb + 1)) mix_phase(a, l, lds);
        SEAM(pb + 1);
        for (int rep_ = 0; rep_ < (DUP == 3 ? 2 : 1); ++rep_)
        if (RUN(pb + 2)) {
            pg8::Gemm g{MIX, W2T + (size_t)l * D * EM, T, D, EM}; pg8::StaticOrder S; S.init(T, D, G, (int)blockIdx.x);
            pg8::EpiOutF32 E{OUT};
            pg8::gemm_phase<pg8::EpiOutF32, pg8::StaticOrder, true, true>((LAS unsigned char*)lds, g, S, E);
        }
        SEAM(pb + 2);
        if (RUN(pb + 3)) {
            for (int m = gw; m < T; m += NGW) {
                const float* xr = (l == 0) ? (m < TP ? a.in[0] + (size_t)m * D : a.in[1] + (size_t)(m - TP) * D) : Y + (size_t)m * D;
                row_norm(xr, OUT + (size_t)m * D, a.in[13] + (size_t)l * D, Y + (size_t)m * D,
                         a.in[4] + (size_t)(l + 1 < DEPTH ? l + 1 : 0) * D, (l + 1 < DEPTH) ? H + (size_t)m * D : nullptr, lane);
            }
        }
        SEAM(pb + 3);
    }
#undef RUN
#undef SEAM
}

#ifndef N_LAUNCH_SPLIT
#define N_LAUNCH_SPLIT 0
#endif

extern "C" void kernel_launch(void* const* d_in, const int* in_sizes, int n_in, void* d_out, int out_size, void* d_ws, size_t ws_size, hipStream_t stream) {
    static int grid = 0;
    if (grid == 0) {
        if (n_in != 14 || (size_t)out_size != O_END || ws_size < WS_END) { fprintf(stderr, "kernel_launch: unexpected sizes n_in %d out %d ws %zu (need %zu)\n", n_in, out_size, ws_size, (size_t)WS_END); grid = -1; return; }
        int dev = 0, cus = 0, per_cu = 0;
        hipGetDevice(&dev); hipDeviceGetAttribute(&cus, hipDeviceAttributeMultiprocessorCount, dev);
        if (hipFuncSetAttribute((const void*)fwd_kernel, hipFuncAttributeMaxDynamicSharedMemorySize, LDS_BYTES) != hipSuccess) { fprintf(stderr, "kernel_launch: hipFuncSetAttribute failed\n"); grid = -1; return; }
        if (hipOccupancyMaxActiveBlocksPerMultiprocessor(&per_cu, (const void*)fwd_kernel, 512, LDS_BYTES) != hipSuccess || per_cu < 1) { fprintf(stderr, "kernel_launch: occupancy query says %d\n", per_cu); per_cu = 1; }
        (void)hipGetLastError();
        grid = cus;
    }
    if (grid < 0) return;
    if (hipMemsetAsync((char*)d_ws + WS_CTL, 0, 64 * 1024, stream) != hipSuccess) { fprintf(stderr, "kernel_launch: memset failed\n"); return; }
    Args a{};
    for (int i = 0; i < 14; ++i) a.in[i] = (const float*)d_in[i];
    a.out = (float*)d_out; a.ws = (unsigned char*)d_ws;
#if N_LAUNCH_SPLIT
    for (int p = 0; p < NPHASE; ++p) { a.ph_lo = p; a.ph_hi = p + 1; hipLaunchKernelGGL(fwd_kernel, dim3(grid), dim3(512), LDS_BYTES, stream, a); }
#else
    a.ph_lo = 0; a.ph_hi = NPHASE;
    void* args[] = {&a};
    hipError_t e = hipLaunchCooperativeKernel((const void*)fwd_kernel, dim3(grid), dim3(512), args, LDS_BYTES, stream);
    if (e != hipSuccess) fprintf(stderr, "cooperative launch failed: %s (grid %d)\n", hipGetErrorString(e), grid);
#endif
}
```

```cpp
#include <hip/hip_runtime.h>
#include <hip/hip_cooperative_groups.h>
#include <cstdio>
#include <cstdint>
namespace cg = cooperative_groups;

#define LAS __attribute__((address_space(3)))
typedef unsigned short bf16_t;
typedef short bf16x8 __attribute__((ext_vector_type(8)));
typedef float f32x4 __attribute__((ext_vector_type(4)));
typedef unsigned u32x4 __attribute__((ext_vector_type(4)));
typedef unsigned u32x2 __attribute__((ext_vector_type(2)));

constexpr int TP = 16384, TS = 1024, T = TP + TS, D = 1024, NIN = 6400, EM = 2048, DEPTH = 4;
constexpr int WA = 768, WB = 512, WC = 768;
constexpr int C_U = 0, C_V = 768, C_ZA = 1536, C_P = 2304, C_ZB = 2816, C_XC = 3328, C_BG = 4096, C_CG = 4864, C_ZC = 5632;
constexpr int NP2 = 4096;
constexpr int CU2 = 0, CV2 = 768, CP2 = 1536, CGB2 = 2048, CCX2 = 2560, CGC2 = 3328;
constexpr float EPS = 1e-6f;
constexpr size_t O_Y = 0, O_NSPP = (size_t)T * D, O_NSCP = O_NSPP + 4 * 8 * 15 * 512, O_NSPS = O_NSCP + 4 * 8 * 2 * 768,
                 O_NSCS = O_NSPS + 4 * 128 * 15 * 512, O_NSV = O_NSCS + 4 * 128 * 2 * 768, O_END = O_NSV + 4 * 128 * 8 * 768;
constexpr size_t MiB = 1u << 20;
constexpr size_t WS_CTL = 0, WS_W1T = 1 * MiB, WS_W2T = 51 * MiB, WS_WPG = 67 * MiB, WS_WSM = 67 * MiB + 512 * 1024, WS_VSS = 69 * MiB,
                 WS_H = 70 * MiB, WS_MIX = 104 * MiB, WS_PROJ = 172 * MiB, WS_OUT = WS_PROJ, WS_END = WS_PROJ + (size_t)T * NP2 * 2;
constexpr int LDS_BYTES = 131072 + 4096;
__device__ __forceinline__ float silu(float x) { return x / (1.f + __expf(-x)); }
constexpr int NPHASE = 1 + 4 * DEPTH;

namespace pg8 {
constexpr int BM = 256, BK = 64, HALF = 128, HTB = HALF * BK * 2, STAGE_BYTES = 8 * HTB, NXCD = 8, WGM = 8;
__host__ __device__ __forceinline__ int lds_byte(int r, int c) { const int st = (r >> 4) * 2 + (c >> 5), rr = r & 15, cc = c & 31, ob = rr * 64 + cc * 2; return st * 1024 + (ob ^ (((ob >> 9) & 1) << 5)); }
__host__ __device__ __forceinline__ void stage_rc(int b, int& R, int& C) { const int st = b / 1024, sb = b % 1024, swz = sb ^ (((sb >> 9) & 1) << 5); R = (st >> 1) * 16 + swz / 64; C = (st & 1) * 32 + (swz % 64) / 2; }
__host__ __device__ __forceinline__ int perm32(int rho) { const int n = rho >> 4, i = rho & 15; return 8 * (i >> 2) + 4 * n + (i & 3); }
struct Unit { int pm, pn; };
struct Gemm { const bf16_t* A; const bf16_t* Bt; int M, N, K; };
struct StaticOrder {
    int nM, nN, nwg, G, c;
    __host__ __device__ void init(int M, int N, int G_, int c_) { nM = M / BM; nN = N / BM; nwg = nM * nN; G = G_; c = c_; }
    __host__ __device__ bool next(int i, Unit& u) const {
        const long L = (long)i * G + c; if (L >= nwg) return false;
        int wgid = (int)L; { const int q = nwg / NXCD, r = nwg % NXCD, xcd = wgid % NXCD, off = wgid / NXCD; wgid = (xcd < r ? xcd * (q + 1) : r * (q + 1) + (xcd - r) * q) + off; }
        const int nig = WGM * nN, gid = wgid / nig, fm = gid * WGM, gsz = (nM - fm) < WGM ? (nM - fm) : WGM;
        u.pm = fm + ((wgid % nig) % gsz); u.pn = (wgid % nig) / gsz; return true;
    }
    __device__ __forceinline__ void a_ready(const Unit&) const {}
    __device__ __forceinline__ void done(const Unit&) const {}
};
__device__ __forceinline__ unsigned cvt_pk_bf16(float lo, float hi) { unsigned r; asm volatile("v_cvt_pk_bf16_f32 %0, %1, %2" : "=v"(r) : "v"(lo), "v"(hi)); return r; }

struct EpiProj {
    static constexpr bool PERM = true, AFTER_DRAIN = false;
    bf16_t* O; float* vss; const float* ps;
    __device__ __forceinline__ void operator()(const f32x4 (&acc)[2][2][4][2], const Unit& u, int wr, int wc, int fr, int fq) const {
        const int tau = u.pn; const int row0 = u.pm * BM + wr * 64 + fr; const int ch0 = wc * 32 + 8 * fq;
        if (tau >= 6 && tau < 9) {
            const int col0 = CV2 + 256 * (tau - 6) + ch0;
#pragma unroll
            for (int ai = 0; ai < 2; ++ai)
#pragma unroll
                for (int m = 0; m < 4; ++m) { bf16_t* rowp = O + (size_t)(row0 + ai * HALF + m * 16) * NP2 + col0;
#pragma unroll
                    for (int bj = 0; bj < 2; ++bj) { const f32x4 v0 = acc[ai][bj][m][0], v1 = acc[ai][bj][m][1];
                        u32x4 w; w.x = cvt_pk_bf16(v0[0], v0[1]); w.y = cvt_pk_bf16(v0[2], v0[3]); w.z = cvt_pk_bf16(v1[0], v1[1]); w.w = cvt_pk_bf16(v1[2], v1[3]);
                        *(u32x4*)(rowp + bj * HALF) = w; } }
            float* dst = vss + (size_t)((tau - 6) * 4 + wc) * T;
#pragma unroll
            for (int ai = 0; ai < 2; ++ai)
#pragma unroll
                for (int m = 0; m < 4; ++m) { float s = 0.f;
#pragma unroll
                    for (int bj = 0; bj < 2; ++bj)
#pragma unroll
                        for (int n = 0; n < 2; ++n) { const f32x4 x = acc[ai][bj][m][n]; s += (x[0] * x[0] + x[1] * x[1]) + (x[2] * x[2] + x[3] * x[3]); }
                    s += __shfl_xor(s, 16); s += __shfl_xor(s, 32);
                    if (fq == 0) dst[row0 + ai * HALF + m * 16] = s; }
        } else {
            int kind, ocol;
            if (tau < 6) { kind = 0; ocol = CU2 + 128 * tau; } else if (tau < 13) { kind = 1; ocol = CP2 + 128 * (tau - 9); }
            else if (tau < 19) { kind = 2; ocol = CCX2 + 128 * (tau - 13); } else { kind = 0; ocol = CGC2 + 128 * (tau - 19); }
            f32x4 p0 = {1.f, 1.f, 1.f, 1.f}, p1 = p0;
            if (kind == 1) { p0 = *(const f32x4*)(ps + 128 * (tau - 9) + ch0); p1 = *(const f32x4*)(ps + 128 * (tau - 9) + ch0 + 4); }
#pragma unroll
            for (int ai = 0; ai < 2; ++ai)
#pragma unroll
                for (int m = 0; m < 4; ++m) { bf16_t* rowp = O + (size_t)(row0 + ai * HALF + m * 16) * NP2 + ocol + ch0;
                    const f32x4 a0 = acc[ai][0][m][0], a1 = acc[ai][0][m][1], b0 = acc[ai][1][m][0], b1 = acc[ai][1][m][1];
                    f32x4 o0, o1;
                    if (kind == 2) { o0 = a0 * b0; o1 = a1 * b1; }
                    else { f32x4 s0, s1;
#pragma unroll
                        for (int j = 0; j < 4; ++j) { s0[j] = silu(b0[j]); s1[j] = silu(b1[j]); }
                        if (kind == 0) { o0 = a0 * s0; o1 = a1 * s1; }
                        else { o0 = s0 * p0; o1 = s1 * p1;
                            u32x4 w; w.x = cvt_pk_bf16(a0[0], a0[1]); w.y = cvt_pk_bf16(a0[2], a0[3]); w.z = cvt_pk_bf16(a1[0], a1[1]); w.w = cvt_pk_bf16(a1[2], a1[3]);
                            *(u32x4*)rowp = w; rowp += (CGB2 - CP2); } }
                    u32x4 w; w.x = cvt_pk_bf16(o0[0], o0[1]); w.y = cvt_pk_bf16(o0[2], o0[3]); w.z = cvt_pk_bf16(o1[0], o1[1]); w.w = cvt_pk_bf16(o1[2], o1[3]);
                    *(u32x4*)rowp = w; }
        }
    }
};
struct EpiOutF32 {
    static constexpr bool PERM = false, AFTER_DRAIN = false;
    float* O;
    __device__ __forceinline__ void operator()(const f32x4 (&acc)[2][2][4][2], const Unit& u, int wr, int wc, int fr, int fq) const {
        const int row0 = u.pm * BM + wr * 64 + fr; const int col0 = u.pn * BM + wc * 32 + 4 * fq;
#pragma unroll
        for (int ai = 0; ai < 2; ++ai)
#pragma unroll
            for (int m = 0; m < 4; ++m) { float* rowp = O + (size_t)(row0 + ai * HALF + m * 16) * D + col0;
#pragma unroll
                for (int bj = 0; bj < 2; ++bj)
#pragma unroll
                    for (int n = 0; n < 2; ++n) *(f32x4*)(rowp + bj * HALF + n * 16) = acc[ai][bj][m][n]; }
    }
};

template <class Epi, class Sched, bool ALIGN_EPI = false, bool SP2 = false>
__device__ __forceinline__ void gemm_phase(LAS unsigned char* lds, const Gemm g, const Sched& S, const Epi& E) {
    int tid_ = threadIdx.x; asm volatile("" : "+v"(tid_));
    const int tid = tid_, wid = __builtin_amdgcn_readfirstlane(tid >> 6), lane = tid & 63, wr = wid >> 2, wc = wid & 3, fr = lane & 15, fq = lane >> 4;
    const int K = g.K, nt = K / BK;
    unsigned voffA[2], voffB[2];
#pragma unroll
    for (int i = 0; i < 2; ++i) { int R, C; stage_rc(tid * 16 + i * 8192, R, C); const int Rb = Epi::PERM ? ((R & ~31) + perm32(R & 31)) : R;
        voffA[i] = (unsigned)(R * K + C) * 2u; voffB[i] = (unsigned)(Rb * K + C) * 2u; }
    const size_t kstep = (size_t)(BK * 2);
    const size_t hstep = (size_t)HALF * K * 2;
    const size_t tstep = 2 * hstep;
    const unsigned ldsw = (unsigned)wid * 1024u;
    const int aoff = lds_byte(wr * 64 + fr, fq * 8), boff = lds_byte(wc * 32 + fr, fq * 8);
#define PG8_SA(b, h) (((b) * 2 + (h)) * HTB)
#define PG8_SB(b, h) ((4 + (b) * 2 + (h)) * HTB)
#define PG8_STAGE(bufoff, gbase, voff) do { _Pragma("unroll") for (int _i = 0; _i < 2; ++_i) \
        __builtin_amdgcn_global_load_lds((const unsigned*)((const char*)(gbase) + (voff)[_i]), (LAS unsigned*)(lds + (bufoff) + ldsw + _i * 8192), 16, 0, 0); } while (0)
#define PG8_LDA(dst, b, h) do { _Pragma("unroll") for (int m = 0; m < 4; ++m) _Pragma("unroll") for (int k = 0; k < 2; ++k) dst[m][k] = *(const LAS bf16x8*)(lds + PG8_SA(b, h) + aoff + m * 2048 + k * 1024); } while (0)
#define PG8_LDB(dst, b, h) do { _Pragma("unroll") for (int n = 0; n < 2; ++n) _Pragma("unroll") for (int k = 0; k < 2; ++k) dst[n][k] = *(const LAS bf16x8*)(lds + PG8_SB(b, h) + boff + n * 2048 + k * 1024); } while (0)
#define PG8_MMA(ai, bj, At, Bt) do { __builtin_amdgcn_s_setprio(1); _Pragma("unroll") for (int m = 0; m < 4; ++m) _Pragma("unroll") for (int n = 0; n < 2; ++n) _Pragma("unroll") for (int k = 0; k < 2; ++k) \
        acc[ai][bj][m][n] = __builtin_amdgcn_mfma_f32_16x16x32_bf16(Bt[n][k], At[m][k], acc[ai][bj][m][n], 0, 0, 0); __builtin_amdgcn_s_setprio(0); } while (0)
#define PG8_WAIT_V(n) asm volatile("s_waitcnt vmcnt(" #n ")" ::: "memory")
#define PG8_WAIT_L(n) asm volatile("s_waitcnt lgkmcnt(" #n ")" ::: "memory")
#define PG8_BAR __builtin_amdgcn_s_barrier()
#define PG8_SCHED __builtin_amdgcn_sched_barrier(0)
    Unit cur, nxt; int ui = 0;
    if (!S.next(0, cur)) return;
    f32x4 acc[2][2][4][2];
#pragma unroll
    for (int a = 0; a < 2; ++a)
#pragma unroll
        for (int b = 0; b < 2; ++b)
#pragma unroll
            for (int m = 0; m < 4; ++m)
#pragma unroll
                for (int n = 0; n < 2; ++n) acc[a][b][m][n] = (f32x4){0.f, 0.f, 0.f, 0.f};
    bf16x8 At[4][2], B0[2][2], B1[2][2];
    const char* cA = (const char*)g.A + (size_t)cur.pm * tstep; const char* cB = (const char*)g.Bt + (size_t)cur.pn * tstep;
    S.a_ready(cur);
    if constexpr (SP2) {
        PG8_STAGE(PG8_SB(0, 0), cB, voffB); PG8_STAGE(PG8_SB(0, 1), cB + hstep, voffB); PG8_STAGE(PG8_SA(0, 0), cA, voffA); PG8_STAGE(PG8_SA(0, 1), cA + hstep, voffA);
        if (wr == 1) PG8_BAR;
        PG8_WAIT_V(2); PG8_BAR;
        PG8_STAGE(PG8_SB(1, 0), cB + kstep, voffB); PG8_STAGE(PG8_SA(1, 0), cA + kstep, voffA); PG8_STAGE(PG8_SB(1, 1), cB + hstep + kstep, voffB);
        PG8_WAIT_V(6); PG8_BAR;
    } else {
        PG8_STAGE(PG8_SB(0, 0), cB, voffB); PG8_STAGE(PG8_SA(0, 0), cA, voffA); PG8_STAGE(PG8_SB(0, 1), cB + hstep, voffB); PG8_STAGE(PG8_SA(0, 1), cA + hstep, voffA);
        if (wr == 1) PG8_BAR;
        PG8_WAIT_V(4); PG8_BAR;
        PG8_STAGE(PG8_SB(1, 0), cB + kstep, voffB); PG8_STAGE(PG8_SA(1, 0), cA + kstep, voffA); PG8_STAGE(PG8_SB(1, 1), cB + hstep + kstep, voffB);
        PG8_WAIT_V(6); PG8_BAR;
    }
    for (;;) {
        const bool has_next = S.next(ui + 1, nxt);
        const char* nA = has_next ? (const char*)g.A + (size_t)nxt.pm * tstep : cA; const char* nB = has_next ? (const char*)g.Bt + (size_t)nxt.pn * tstep : cB;
        for (int t = 0; t < nt; t += 2) {
            const bool last = (t == nt - 2);
            const char* a1 = cA + (size_t)(t + 1) * kstep;
            const char* a2 = last ? nA : cA + (size_t)(t + 2) * kstep; const char* b2 = last ? nB : cB + (size_t)(t + 2) * kstep;
            const char* a3 = a2 + kstep; const char* b3 = b2 + kstep;
            if (last && has_next) S.a_ready(nxt);
            if constexpr (SP2) {
            PG8_LDB(B0, 0, 0); PG8_LDB(B1, 0, 1); PG8_SCHED; PG8_LDA(At, 0, 0); PG8_STAGE(PG8_SA(1, 1), a1 + hstep, voffA);
            PG8_WAIT_V(8); PG8_WAIT_L(0); PG8_BAR; PG8_MMA(0, 0, At, B0); PG8_MMA(0, 1, At, B1); PG8_BAR; PG8_SCHED;
            PG8_LDA(At, 0, 1); PG8_STAGE(PG8_SB(0, 0), b2, voffB); PG8_STAGE(PG8_SB(0, 1), b2 + hstep, voffB); PG8_STAGE(PG8_SA(0, 0), a2, voffA);
            PG8_WAIT_V(8); PG8_WAIT_L(0); PG8_BAR; PG8_MMA(1, 0, At, B0); PG8_MMA(1, 1, At, B1); PG8_BAR; PG8_SCHED;
            PG8_LDB(B0, 1, 0); PG8_LDB(B1, 1, 1); PG8_SCHED; PG8_LDA(At, 1, 0); PG8_STAGE(PG8_SA(0, 1), a2 + hstep, voffA);
            PG8_WAIT_V(8); PG8_WAIT_L(0); PG8_BAR; PG8_MMA(0, 0, At, B0); PG8_MMA(0, 1, At, B1); PG8_BAR; PG8_SCHED;
            PG8_LDA(At, 1, 1); PG8_STAGE(PG8_SB(1, 0), b3, voffB); PG8_STAGE(PG8_SB(1, 1), b3 + hstep, voffB); PG8_STAGE(PG8_SA(1, 0), a3, voffA);
            PG8_WAIT_V(8); PG8_WAIT_L(0); PG8_BAR; PG8_MMA(1, 0, At, B0); PG8_MMA(1, 1, At, B1); PG8_BAR; PG8_SCHED;
            } else {
            PG8_LDB(B0, 0, 0); PG8_SCHED; PG8_LDA(At, 0, 0); PG8_STAGE(PG8_SA(1, 1), a1 + hstep, voffA);
            PG8_WAIT_L(8); PG8_BAR; PG8_WAIT_L(0); PG8_MMA(0, 0, At, B0); PG8_BAR; PG8_SCHED;
            PG8_LDB(B1, 0, 1); PG8_STAGE(PG8_SB(0, 0), b2, voffB);
            PG8_BAR; PG8_WAIT_L(0); PG8_MMA(0, 1, At, B1); PG8_BAR;
            PG8_LDA(At, 0, 1); PG8_STAGE(PG8_SA(0, 0), a2, voffA);
            PG8_BAR; PG8_WAIT_L(0); PG8_MMA(1, 0, At, B0); PG8_BAR; PG8_SCHED;
            PG8_STAGE(PG8_SB(0, 1), b2 + hstep, voffB);
            PG8_WAIT_V(6); PG8_BAR; PG8_MMA(1, 1, At, B1); PG8_BAR;
            PG8_LDB(B0, 1, 0); PG8_SCHED; PG8_LDA(At, 1, 0); PG8_STAGE(PG8_SA(0, 1), a2 + hstep, voffA);
            PG8_WAIT_L(8); PG8_BAR; PG8_WAIT_L(0); PG8_MMA(0, 0, At, B0); PG8_BAR; PG8_SCHED;
            PG8_LDB(B1, 1, 1); PG8_STAGE(PG8_SB(1, 0), b3, voffB);
            PG8_BAR; PG8_WAIT_L(0); PG8_MMA(0, 1, At, B1); PG8_BAR;
            PG8_LDA(At, 1, 1); PG8_STAGE(PG8_SA(1, 0), a3, voffA);
            PG8_BAR; PG8_WAIT_L(0); PG8_MMA(1, 0, At, B0); PG8_BAR; PG8_SCHED;
            PG8_STAGE(PG8_SB(1, 1), b3 + hstep, voffB);
            PG8_WAIT_V(6); PG8_BAR; PG8_MMA(1, 1, At, B1); PG8_BAR;
            }
        }
        if constexpr (ALIGN_EPI) { if (wr == 0) PG8_BAR; }
        if constexpr (!Epi::AFTER_DRAIN) { E(acc, cur, wr, wc, fr, fq); S.done(cur); }
        if (!has_next) break;
#pragma unroll
        for (int a = 0; a < 2; ++a)
#pragma unroll
            for (int b = 0; b < 2; ++b)
#pragma unroll
                for (int m = 0; m < 4; ++m)
#pragma unroll
                    for (int n = 0; n < 2; ++n) acc[a][b][m][n] = (f32x4){0.f, 0.f, 0.f, 0.f};
        cur = nxt; cA = nA; cB = nB; ++ui;
        if constexpr (ALIGN_EPI) { if (wr == 1) PG8_BAR; }
    }
    PG8_WAIT_V(0);
    if constexpr (!ALIGN_EPI) { if (wr == 0) PG8_BAR; }
    PG8_BAR;
#undef PG8_SA
#undef PG8_SB
#undef PG8_STAGE
#undef PG8_LDA
#undef PG8_LDB
#undef PG8_MMA
#undef PG8_WAIT_V
#undef PG8_WAIT_L
#undef PG8_BAR
#undef PG8_SCHED
}
}

#define LDS_WAIT() asm volatile("s_waitcnt lgkmcnt(0)" ::: "memory")
__device__ __forceinline__ unsigned f2bf(float f) { unsigned u = __builtin_bit_cast(unsigned, f); return (u + 0x7fffu + ((u >> 16) & 1u)) >> 16; }
__device__ __forceinline__ unsigned pk2(float lo, float hi) { return f2bf(lo) | (f2bf(hi) << 16); }
__device__ __forceinline__ float wave_sum(float v) {
#pragma unroll
    for (int o = 1; o < 64; o <<= 1) v += __shfl_xor(v, o);
    return v;
}
__device__ __forceinline__ void ld8(const bf16_t* p, float (&f)[8]) {
    const u32x4 w = *(const u32x4*)p;
    f[0] = __uint_as_float(w.x << 16); f[1] = __uint_as_float(w.x & 0xffff0000u); f[2] = __uint_as_float(w.y << 16); f[3] = __uint_as_float(w.y & 0xffff0000u);
    f[4] = __uint_as_float(w.z << 16); f[5] = __uint_as_float(w.z & 0xffff0000u); f[6] = __uint_as_float(w.w << 16); f[7] = __uint_as_float(w.w & 0xffff0000u);
}
__device__ __forceinline__ void ld4(const bf16_t* p, float (&f)[4]) {
    const u32x2 w = *(const u32x2*)p;
    f[0] = __uint_as_float(w.x << 16); f[1] = __uint_as_float(w.x & 0xffff0000u); f[2] = __uint_as_float(w.y << 16); f[3] = __uint_as_float(w.y & 0xffff0000u);
}
__device__ __forceinline__ void ld8f(const float* p, float (&f)[8]) {
    const f32x4 a = *(const f32x4*)p, b = *(const f32x4*)(p + 4);
    f[0] = a[0]; f[1] = a[1]; f[2] = a[2]; f[3] = a[3]; f[4] = b[0]; f[5] = b[1]; f[6] = b[2]; f[7] = b[3];
}
__device__ __forceinline__ void st8f(float* p, const float (&f)[8]) {
    *(f32x4*)p = (f32x4){f[0], f[1], f[2], f[3]}; *(f32x4*)(p + 4) = (f32x4){f[4], f[5], f[6], f[7]};
}
__device__ __forceinline__ u32x4 pk8(const float (&f)[8]) {
    u32x4 w; w.x = pk2(f[0], f[1]); w.y = pk2(f[2], f[3]); w.z = pk2(f[4], f[5]); w.w = pk2(f[6], f[7]); return w;
}

#define XB_TMO      128
#define XB_XCNT(j)  (256  + 64 * (j))
#define XB_XSUB(j)  (1280 + 64 * (j))
#define XB_XGEN(j)  (2304 + 64 * (j))
#define XB_TOP      3328
#define XB_TOPGEN   3392
#define XCD_BAR_WORDS 3456
#define XB_SPIN_CAP (1u << 22)
__device__ __forceinline__ unsigned xb_ld(unsigned* p)              { return __hip_atomic_load(p, __ATOMIC_RELAXED, __HIP_MEMORY_SCOPE_AGENT); }
__device__ __forceinline__ unsigned xb_add(unsigned* p, unsigned v) { return __hip_atomic_fetch_add(p, v, __ATOMIC_RELAXED, __HIP_MEMORY_SCOPE_AGENT); }
__device__ __forceinline__ unsigned xb_xcc_id() { return (unsigned)__builtin_amdgcn_s_getreg((3 << 11) | 20) & 0xFu; }
#define XB_SPIN(cond, bar) do { unsigned _sp = 0; while (cond) { __builtin_amdgcn_s_sleep(1); \
    if ((++_sp & 255u) == 0u) { if (xb_ld(&(bar)[XB_TMO])) break; if (_sp > XB_SPIN_CAP) { atomicAdd(&(bar)[XB_TMO], 1u); break; } } } } while (0)
struct XcdBarrier { unsigned* bar; unsigned x; volatile LAS unsigned* st; };
__device__ __forceinline__ XcdBarrier xcd_barrier_post(unsigned* bar, volatile LAS unsigned* st) {
    XcdBarrier b; b.bar = bar; b.x = xb_xcc_id(); b.st = st;
    if (threadIdx.x == 0) (void)xb_add(&bar[XB_XCNT(b.x)], 1u);
    return b;
}
__device__ __forceinline__ void xcd_barrier_complete(unsigned* bar, unsigned x, unsigned& nloc, unsigned& nx) {
    const unsigned G = gridDim.x * gridDim.y * gridDim.z;
    unsigned sum, cnt, mine, sp = 0u;
    for (;;) {
        sum = 0u; cnt = 0u; mine = 0u;
#pragma unroll
        for (unsigned j = 0; j < 16; ++j) { const unsigned c = xb_ld(&bar[XB_XCNT(j)]); sum += c; cnt += (c > 0u) ? 1u : 0u; mine = (j == x) ? c : mine; }
        if (sum == G) break;
        __builtin_amdgcn_s_sleep(1);
        if ((++sp & 255u) == 0u) { if (xb_ld(&bar[XB_TMO])) break; if (sp > XB_SPIN_CAP) { atomicAdd(&bar[XB_TMO], 1u); break; } }
    }
    nloc = mine > 0u ? mine : 1u; nx = cnt > 0u ? cnt : 1u;
}
__device__ __forceinline__ void xcd_barrier(const XcdBarrier& b) {
    asm volatile("s_waitcnt vmcnt(0)" ::: "memory");
    __syncthreads();
    if (threadIdx.x == 0) {
        unsigned* bar = b.bar;
        __builtin_amdgcn_s_waitcnt(0);
        unsigned nloc = b.st[0], nx = b.st[1];
        if (nloc == 0u) { xcd_barrier_complete(bar, b.x, nloc, nx); b.st[0] = nloc; b.st[1] = nx; }
        const unsigned old = xb_add(&bar[XB_XSUB(b.x)], 1u);
        const unsigned gen = old / nloc;
        if (old + 1u == (gen + 1u) * nloc) {
            __builtin_amdgcn_fence(__ATOMIC_RELEASE, "agent");
            asm volatile("s_waitcnt vmcnt(0)" ::: "memory");
            const unsigned og = xb_add(&bar[XB_TOP], 1u);
            const unsigned tg = og / nx;
            if (og + 1u == (tg + 1u) * nx) xb_add(&bar[XB_TOPGEN], 1u);
            else XB_SPIN(xb_ld(&bar[XB_TOPGEN]) == tg, bar);
            __builtin_amdgcn_fence(__ATOMIC_ACQUIRE, "agent");
            xb_add(&bar[XB_XGEN(b.x)], 1u);
            asm volatile("s_waitcnt vmcnt(0)" ::: "memory");
        } else {
            XB_SPIN(xb_ld(&bar[XB_XGEN(b.x)]) == gen, bar);
            __builtin_amdgcn_fence(__ATOMIC_ACQUIRE, "agent");
            asm volatile("s_waitcnt vmcnt(0)" ::: "memory");
        }
    }
    __syncthreads();
}

struct Args { const float* in[14]; float* out; unsigned char* ws; int ph_lo, ph_hi; };

__device__ __forceinline__ int w1_src_col(int n0) {
    const int tau = n0 >> 8, c = n0 & 255, bj = c >> 7, cc = c & 127;
    if (tau < 6) return (bj ? C_ZA : C_U) + 128 * tau + cc;
    if (tau < 9) return C_V + 256 * (tau - 6) + c;
    if (tau < 13) return (bj ? C_ZB : C_P) + 128 * (tau - 9) + cc;
    if (tau < 19) return (bj ? C_CG : C_XC) + 128 * (tau - 13) + cc;
    return (bj ? C_ZC : C_BG) + 128 * (tau - 19) + cc;
}
__device__ __forceinline__ void p0_transpose_item(const float* W, int K, int N, bf16_t* WT, LAS float* scr, int k0, int n0s, int n0, int lane) {
#pragma unroll 8
    for (int i = 0; i < 32; ++i) { const int kk = 2 * i + (lane >> 5); scr[kk * 33 + (lane & 31)] = W[(size_t)(k0 + kk) * N + n0s + (lane & 31)]; }
    LDS_WAIT(); asm volatile("" ::: "memory");
    const int c = lane & 7;
#pragma unroll
    for (int j = 0; j < 4; ++j) { const int n = (lane >> 3) + 8 * j; const LAS float* s = scr + (8 * c) * 33 + n;
        u32x4 o; o.x = pk2(s[0 * 33], s[1 * 33]); o.y = pk2(s[2 * 33], s[3 * 33]); o.z = pk2(s[4 * 33], s[5 * 33]); o.w = pk2(s[6 * 33], s[7 * 33]);
        *(u32x4*)(WT + (size_t)(n0 + n) * K + k0 + 8 * c) = o; }
    LDS_WAIT(); asm volatile("" ::: "memory");
}

__device__ __forceinline__ void row_norm(const float* xrow, const float* orow, const float* gpost, float* yout, const float* gpre, bf16_t* hrow, int lane) {
    f32x4 v[4];
#pragma unroll
    for (int j = 0; j < 4; ++j) v[j] = ((const f32x4*)xrow)[lane + 64 * j];
    if (orow) {
        f32x4 o[4]; float s = 0.f;
#pragma unroll
        for (int j = 0; j < 4; ++j) { o[j] = ((const f32x4*)orow)[lane + 64 * j]; s += (o[j][0] * o[j][0] + o[j][1] * o[j][1]) + (o[j][2] * o[j][2] + o[j][3] * o[j][3]); }
        const float rs = rsqrtf(wave_sum(s) * (1.f / D) + EPS);
#pragma unroll
        for (int j = 0; j < 4; ++j) { const f32x4 g = ((const f32x4*)gpost)[lane + 64 * j]; v[j] = v[j] + o[j] * rs * g; ((f32x4*)yout)[lane + 64 * j] = v[j]; }
    }
    if (hrow) {
        float s = 0.f;
#pragma unroll
        for (int j = 0; j < 4; ++j) s += (v[j][0] * v[j][0] + v[j][1] * v[j][1]) + (v[j][2] * v[j][2] + v[j][3] * v[j][3]);
        const float rs = rsqrtf(wave_sum(s) * (1.f / D) + EPS);
#pragma unroll
        for (int j = 0; j < 4; ++j) { const f32x4 g = ((const f32x4*)gpre)[lane + 64 * j]; const f32x4 h = v[j] * rs * g;
            u32x2 w; w.x = pk2(h[0], h[1]); w.y = pk2(h[2], h[3]); ((u32x2*)hrow)[lane + 64 * j] = w; }
    }
}

typedef short v4i16_t __attribute__((ext_vector_type(4)));
constexpr int LDT = 136;
constexpr int LDV = 40;
constexpr int WAVE_LDS = 10240;
__device__ __forceinline__ void unpk8(const u32x4 w, float (&f)[8]) {
    f[0] = __uint_as_float(w.x << 16); f[1] = __uint_as_float(w.x & 0xffff0000u); f[2] = __uint_as_float(w.y << 16); f[3] = __uint_as_float(w.y & 0xffff0000u);
    f[4] = __uint_as_float(w.z << 16); f[5] = __uint_as_float(w.z & 0xffff0000u); f[6] = __uint_as_float(w.w << 16); f[7] = __uint_as_float(w.w & 0xffff0000u);
}
__device__ __forceinline__ float row_rs(const float* vss, int m) {
    float s = 0.f;
#pragma unroll
    for (int p = 0; p < 12; ++p) s += vss[(size_t)p * T + m];
    return rsqrtf(s * (1.f / WA) + EPS);
}

template <int W>
__device__ __forceinline__ void mixB(const Args& a, int l, int g, int blk, LAS unsigned char* Lw, int lane) {
    const bf16_t* PROJ = (const bf16_t*)(a.ws + WS_PROJ);
    bf16_t* MIX = (bf16_t*)(a.ws + WS_MIX);
    const bf16_t* Wpg = (const bf16_t*)(a.ws + WS_WPG) + (size_t)(l * 4 + g) * 128 * 128;
    float* out = a.out;
    const int q = lane & 15, rr = lane >> 4, fr = lane & 15, fq = lane >> 4;
    const int m0 = blk * 32 + rr * 8;
    const bool isS = blk >= 512;
    const int c = g * 128 + q * 8;
    const bf16_t* pr = PROJ + (size_t)m0 * NP2 + CP2 + c;
    LAS bf16_t* L = (LAS bf16_t*)Lw;
    u32x4 P[W + 7];
    int t0 = 0, b;
    if (!isS) {
        t0 = m0 & 2047; b = m0 >> 11;
#pragma unroll
        for (int i = 0; i < W - 1; ++i) { const int off = i - (W - 1); const bool ok = (t0 + off) >= 0;
            u32x4 v = *(const u32x4*)(ok ? pr + (ptrdiff_t)off * NP2 : pr); if (!ok) v = (u32x4){0u, 0u, 0u, 0u}; P[i] = v; }
    } else {
        b = (m0 - TP) >> 3;
        const float* sp = a.in[2] + (size_t)((l * 128 + b) * 15) * WB + c;
#pragma unroll
        for (int i = 0; i < W - 1; ++i) { const int off = i - (W - 1); float v[8]; ld8f(sp + (size_t)(15 + off) * WB, v); P[i] = pk8(v); }
        float* ns = out + O_NSPS + (size_t)((l * 128 + b) * 15) * WB + c;
#pragma unroll
        for (int j = 0; j < 7; ++j) { float v[8]; ld8f(sp + (size_t)(8 + j) * WB, v); st8f(ns + (size_t)j * WB, v); }
    }
#pragma unroll
    for (int j = 0; j < 8; ++j) P[W - 1 + j] = *(const u32x4*)(pr + (size_t)j * NP2);
    float S[8];
#pragma unroll
    for (int k = 0; k < 8; ++k) S[k] = 0.f;
#pragma unroll
    for (int i = 0; i < W; ++i) { float v[8]; unpk8(P[i], v);
#pragma unroll
        for (int k = 0; k < 8; ++k) S[k] += v[k]; }
#pragma unroll
    for (int j = 0; j < 8; ++j) {
        float pc[8]; unpk8(P[W - 1 + j], pc);
        if (j > 0) { float po[8]; unpk8(P[j - 1], po);
#pragma unroll
            for (int k = 0; k < 8; ++k) S[k] += pc[k] - po[k]; }
        const int n = isS ? W : ((t0 + j + 1) < W ? (t0 + j + 1) : W);
        const float inv = 1.f / (float)n;
        float d[8];
#pragma unroll
        for (int k = 0; k < 8; ++k) d[k] = S[k] * inv - pc[k];
        *(LAS u32x4*)(L + (rr * 8 + j) * LDT + q * 8) = pk8(d);
        if (!isS) { if (t0 + j >= 2033) st8f(out + O_NSPP + (size_t)((l * 8 + b) * 15 + (t0 + j - 2033)) * WB + c, pc); }
        else st8f(out + O_NSPS + (size_t)((l * 128 + b) * 15 + 7 + j) * WB + c, pc);
    }
    asm volatile("s_waitcnt lgkmcnt(0)" ::: "memory");
    f32x4 acc[2][8];
#pragma unroll
    for (int mt = 0; mt < 2; ++mt)
#pragma unroll
        for (int nt = 0; nt < 8; ++nt) acc[mt][nt] = (f32x4){0.f, 0.f, 0.f, 0.f};
#pragma unroll 1
    for (int ks = 0; ks < 4; ++ks) {
        bf16x8 af[2];
#pragma unroll
        for (int mt = 0; mt < 2; ++mt) af[mt] = *(const LAS bf16x8*)(L + (mt * 16 + fr) * LDT + ks * 32 + fq * 8);
#pragma unroll
        for (int nt = 0; nt < 8; ++nt) {
            const int erow = (nt >> 1) * 32 + 8 * (fr >> 2) + 4 * (nt & 1) + (fr & 3);
            const bf16x8 bfr = *(const bf16x8*)(Wpg + (size_t)erow * 128 + ks * 32 + fq * 8);
#pragma unroll
            for (int mt = 0; mt < 2; ++mt) acc[mt][nt] = __builtin_amdgcn_mfma_f32_16x16x32_bf16(bfr, af[mt], acc[mt][nt], 0, 0, 0);
        }
    }
#pragma unroll
    for (int mt = 0; mt < 2; ++mt) {
        const int m = blk * 32 + mt * 16 + fr;
#pragma unroll
        for (int np = 0; np < 4; ++np) {
            const int e = g * 128 + np * 32 + 8 * fq;
            float gb[8], o[8]; ld8(PROJ + (size_t)m * NP2 + CGB2 + e, gb);
#pragma unroll
            for (int k = 0; k < 4; ++k) { o[k] = acc[mt][2 * np][k] * gb[k]; o[4 + k] = acc[mt][2 * np + 1][k] * gb[4 + k]; }
            *(u32x4*)(MIX + (size_t)m * EM + 768 + e) = pk8(o);
        }
    }
    asm volatile("s_waitcnt lgkmcnt(0)" ::: "memory");
}

__device__ __forceinline__ void mixA(const Args& a, int l, int ck, int h, int cs, LAS unsigned char* Lw, int lane) {
    const bf16_t* PROJ = (const bf16_t*)(a.ws + WS_PROJ);
    bf16_t* MIX = (bf16_t*)(a.ws + WS_MIX);
    const float* vss = (const float*)(a.ws + WS_VSS);
    const bf16_t* Wsm = (const bf16_t*)(a.ws + WS_WSM) + (size_t)(l * 6 + h) * 128 * 128;
    const int fr = lane & 15, fq = lane >> 4;
    const int mbase = ck * 128, ccol = h * 128 + cs * 32;
    LAS bf16_t* L = (LAS bf16_t*)Lw;
    {
        const int q4 = lane & 3, rr = lane >> 2;
        float gv[8]; ld8f(a.in[6] + (size_t)l * WA + ccol + q4 * 8, gv);
#pragma unroll
        for (int it = 0; it < 8; ++it) {
            const int s = rr + 16 * it, m = mbase + s;
            float v[8]; ld8(PROJ + (size_t)m * NP2 + CV2 + ccol + q4 * 8, v);
            const float rs = row_rs(vss, m);
#pragma unroll
            for (int k = 0; k < 8; ++k) v[k] = v[k] * rs * gv[k];
            *(LAS u32x4*)(L + s * LDV + q4 * 8) = pk8(v);
        }
    }
    asm volatile("s_waitcnt lgkmcnt(0)" ::: "memory");
    f32x4 acc[8][2];
#pragma unroll
    for (int mt = 0; mt < 8; ++mt)
#pragma unroll
        for (int nt = 0; nt < 2; ++nt) acc[mt][nt] = (f32x4){0.f, 0.f, 0.f, 0.f};
#pragma unroll
    for (int ks = 0; ks < 4; ++ks) {
        bf16x8 bfr[2];
#pragma unroll
        for (int nt = 0; nt < 2; ++nt) {
            const LAS bf16_t* p0 = L + (ks * 32 + fq * 8 + (fr >> 2)) * LDV + 8 * (fr & 3) + 4 * nt;
            const v4i16_t lo = __builtin_amdgcn_ds_read_tr16_b64_v4i16((LAS v4i16_t*)p0);
            const v4i16_t hi = __builtin_amdgcn_ds_read_tr16_b64_v4i16((LAS v4i16_t*)(p0 + 4 * LDV));
            bfr[nt] = (bf16x8){lo[0], lo[1], lo[2], lo[3], hi[0], hi[1], hi[2], hi[3]};
        }
#pragma unroll
        for (int mt = 2 * ks; mt < 8; ++mt) {
            const bf16x8 af = *(const bf16x8*)(Wsm + (size_t)(mt * 16 + fr) * 128 + ks * 32 + fq * 8);
#pragma unroll
            for (int nt = 0; nt < 2; ++nt) acc[mt][nt] = __builtin_amdgcn_mfma_f32_16x16x32_bf16(bfr[nt], af, acc[mt][nt], 0, 0, 0);
        }
    }
#pragma unroll
    for (int mt = 0; mt < 8; ++mt) {
        const int t = mt * 16 + fr, m = mbase + t;
        const float bsp = a.in[8][(size_t)(l * 6 + h) * 128 + t];
        float ug[8], o[8]; ld8(PROJ + (size_t)m * NP2 + CU2 + ccol + 8 * fq, ug);
#pragma unroll
        for (int k = 0; k < 4; ++k) { o[k] = ug[k] * (acc[mt][0][k] + bsp); o[4 + k] = ug[4 + k] * (acc[mt][1][k] + bsp); }
        *(u32x4*)(MIX + (size_t)m * EM + ccol + 8 * fq) = pk8(o);
    }
    asm volatile("s_waitcnt lgkmcnt(0)" ::: "memory");
}

__device__ __forceinline__ void mixAS(const Args& a, int l, int sb, int h, int lane) {
    const bf16_t* PROJ = (const bf16_t*)(a.ws + WS_PROJ);
    bf16_t* MIX = (bf16_t*)(a.ws + WS_MIX);
    const float* vss = (const float*)(a.ws + WS_VSS);
    const int q = lane & 15, rr = lane >> 4;
    const int m0 = TP + sb * 32 + rr * 8, b = sb * 4 + rr, c = h * 128 + q * 8;
    float gv[8]; ld8f(a.in[6] + (size_t)l * WA + c, gv);
    float vn[8][8];
#pragma unroll
    for (int s = 0; s < 8; ++s) {
        float v[8]; ld8(PROJ + (size_t)(m0 + s) * NP2 + CV2 + c, v);
        const float rs = row_rs(vss, m0 + s);
#pragma unroll
        for (int k = 0; k < 8; ++k) vn[s][k] = v[k] * rs * gv[k];
    }
    const float* wsp = a.in[7] + (size_t)(l * 6 + h) * 128 * 128;
    const float* bsp = a.in[8] + (size_t)(l * 6 + h) * 128;
#pragma unroll
    for (int t = 0; t < 8; ++t) {
        float S[8];
#pragma unroll
        for (int k = 0; k < 8; ++k) S[k] = bsp[t];
#pragma unroll
        for (int s = 0; s <= t; ++s) { const float w = wsp[t * 128 + s];
#pragma unroll
            for (int k = 0; k < 8; ++k) S[k] += w * vn[s][k]; }
        float ug[8], o[8]; ld8(PROJ + (size_t)(m0 + t) * NP2 + CU2 + c, ug);
#pragma unroll
        for (int k = 0; k < 8; ++k) o[k] = ug[k] * S[k];
        *(u32x4*)(MIX + (size_t)(m0 + t) * EM + c) = pk8(o);
        st8f(a.out + O_NSV + (size_t)((l * 128 + b) * 8 + t) * WA + c, vn[t]);
    }
}

__device__ __forceinline__ void mixC(const Args& a, int l, int blk, int cs, int lane) {
    const bf16_t* PROJ = (const bf16_t*)(a.ws + WS_PROJ);
    bf16_t* MIX = (bf16_t*)(a.ws + WS_MIX);
    float* out = a.out;
    const int q = lane & 15, rr = lane >> 4;
    const int m0 = blk * 32 + rr * 8, c = cs * 128 + q * 8;
    const bool isS = blk >= 512;
    const bf16_t* pr = PROJ + (size_t)m0 * NP2 + c;
    float X[10][8];
    int t0 = 0, b;
    if (!isS) {
        t0 = m0 & 2047; b = m0 >> 11;
        const bool ok = t0 > 0;
        const u32x4 z = {0u, 0u, 0u, 0u};
        u32x4 v0 = *(const u32x4*)(ok ? pr + CCX2 - 2 * NP2 : pr + CCX2), v1 = *(const u32x4*)(ok ? pr + CCX2 - NP2 : pr + CCX2);
        if (!ok) { v0 = z; v1 = z; }
        unpk8(v0, X[0]); unpk8(v1, X[1]);
    } else {
        b = (m0 - TP) >> 3;
        ld8f(a.in[3] + (size_t)((l * 128 + b) * 2 + 0) * WC + c, X[0]); ld8f(a.in[3] + (size_t)((l * 128 + b) * 2 + 1) * WC + c, X[1]);
    }
#pragma unroll
    for (int j = 0; j < 8; ++j) ld8(pr + (size_t)j * NP2 + CCX2, X[2 + j]);
    float w0[8], w1[8], w2[8];
    ld8f(a.in[11] + (size_t)(l * 3 + 0) * WC + c, w0); ld8f(a.in[11] + (size_t)(l * 3 + 1) * WC + c, w1); ld8f(a.in[11] + (size_t)(l * 3 + 2) * WC + c, w2);
#pragma unroll
    for (int j = 0; j < 8; ++j) {
        float gc[8], o[8]; ld8(pr + (size_t)j * NP2 + CGC2, gc);
#pragma unroll
        for (int k = 0; k < 8; ++k) o[k] = gc[k] * (w0[k] * X[j][k] + w1[k] * X[j + 1][k] + w2[k] * X[j + 2][k]);
        *(u32x4*)(MIX + (size_t)(m0 + j) * EM + 1280 + c) = pk8(o);
    }
    if (!isS) { if (t0 == 2040) { st8f(out + O_NSCP + (size_t)((l * 8 + b) * 2 + 0) * WC + c, X[8]); st8f(out + O_NSCP + (size_t)((l * 8 + b) * 2 + 1) * WC + c, X[9]); } }
    else { st8f(out + O_NSCS + (size_t)((l * 128 + b) * 2 + 0) * WC + c, X[8]); st8f(out + O_NSCS + (size_t)((l * 128 + b) * 2 + 1) * WC + c, X[9]); }
}

__device__ __forceinline__ void mix_phase(const Args& a, int l_, unsigned char* lds, int gw, int NGW) {
    int l = l_;
    int tid_ = threadIdx.x; asm volatile("" : "+v"(tid_));
    const int lane = tid_ & 63, wave = __builtin_amdgcn_readfirstlane(tid_ >> 6);
    LAS unsigned char* Lw = (LAS unsigned char*)lds + wave * WAVE_LDS;
    constexpr int NA = 128 * 24, NB = 544 * 4, NC = 544 * 6, NAS = 32 * 6;
    for (int job = gw; job < NA + NB + NC + NAS; job += NGW) {
        int r = job; asm volatile("" : "+s"(l));
        if (r < NA) { const int ck = r / 24, rem = r % 24; mixA(a, l, ck, rem >> 2, rem & 3, Lw, lane); continue; } r -= NA;
        if (r < NB) { const int blk = r >> 2, g = r & 3;
            if (g == 0) mixB<2>(a, l, 0, blk, Lw, lane); else if (g == 1) mixB<4>(a, l, 1, blk, Lw, lane);
            else if (g == 2) mixB<8>(a, l, 2, blk, Lw, lane); else mixB<16>(a, l, 3, blk, Lw, lane);
            continue; } r -= NB;
        if (r < NC) { mixC(a, l, r / 6, r % 6, lane); continue; } r -= NC;
        mixAS(a, l, r / 6, r % 6, lane);
    }
}

__global__ void __launch_bounds__(512, 2) fwd_kernel(Args a) {
    extern __shared__ __attribute__((aligned(16))) unsigned char lds[];
    cg::grid_group grid = cg::this_grid();
    const int tid0 = threadIdx.x, wave = __builtin_amdgcn_readfirstlane(tid0 >> 6);
    const int G = gridDim.x;
    const int gw = blockIdx.x * 8 + wave, NGW = G * 8;
    const int lo = a.ph_lo, hi = a.ph_hi;
    unsigned char* ws = a.ws;
    bf16_t* W1T = (bf16_t*)(ws + WS_W1T); bf16_t* W2T = (bf16_t*)(ws + WS_W2T); bf16_t* WPG = (bf16_t*)(ws + WS_WPG); bf16_t* WSM = (bf16_t*)(ws + WS_WSM);
    bf16_t* H = (bf16_t*)(ws + WS_H); bf16_t* MIX = (bf16_t*)(ws + WS_MIX); bf16_t* PROJ = (bf16_t*)(ws + WS_PROJ); float* OUT = (float*)(ws + WS_OUT);
    float* VSS = (float*)(ws + WS_VSS);
    float* Y = a.out + O_Y;
#define RUN(k) (lo <= (k) && (k) < hi)
#define SEAM(k) do { if (RUN(k) && RUN((k) + 1)) { xcd_barrier(bar); if (DUP == 6) xcd_barrier(bar); } } while (0)
    volatile LAS unsigned* misc = (volatile LAS unsigned*)((LAS unsigned char*)lds + 131072 + 2048);
    if (tid0 < 4) misc[tid0] = 0u;
    __syncthreads();
    XcdBarrier bar = xcd_barrier_post((unsigned*)(ws + WS_CTL) + 4096, misc);
    if (lo < 0) grid.sync();

#ifndef DUP
#define DUP 0
#endif
    for (int rep_ = 0; rep_ < (DUP == 5 ? 2 : 1); ++rep_)
    if (RUN(0)) {
        int tid = threadIdx.x; asm volatile("" : "+v"(tid)); const int lane = tid & 63;
        LAS float* scr = (LAS float*)((LAS unsigned char*)lds + wave * 16384);
        constexpr int I1 = 16 * 200, I2 = 32 * 32, IP = 2 * 4;
        constexpr int NITEMS = 4 * I1 + 4 * I2 + 16 * IP;
        for (int it = gw; it < NITEMS; it += NGW) {
            int r = it;
            if (r < 4 * I1) { const int l = r / I1, it1 = r % I1, k0 = 64 * (it1 / 200), n0 = 32 * (it1 % 200);
                p0_transpose_item(a.in[5] + (size_t)l * D * NIN, D, NIN, W1T + (size_t)l * NIN * D, scr, k0, w1_src_col(n0), n0, lane); continue; } r -= 4 * I1;
            if (r < 4 * I2) { const int l = r / I2, it2 = r % I2, k0 = 64 * (it2 / 32), n0 = 32 * (it2 % 32);
                p0_transpose_item(a.in[12] + (size_t)l * EM * D, EM, D, W2T + (size_t)l * D * EM, scr, k0, n0, n0, lane); continue; } r -= 4 * I2;
            { const int mi = r / IP, it3 = r % IP, k0 = 64 * (it3 / 4), n0 = 32 * (it3 % 4);
                p0_transpose_item(a.in[9] + (size_t)mi * 128 * 128, 128, 128, WPG + (size_t)mi * 128 * 128, scr, k0, n0, n0, lane); }
        }
        for (int idx = blockIdx.x * 512 + tid; idx < 4 * 6 * 128 * 16; idx += G * 512) {
            const int s0 = (idx & 15) * 8, t = (idx >> 4) & 127;
            float v[8]; ld8f(a.in[7] + (size_t)idx * 8, v);
#pragma unroll
            for (int i = 0; i < 8; ++i) if (s0 + i > t) v[i] = 0.f;
            *(u32x4*)(WSM + (size_t)idx * 8) = pk8(v);
        }
        for (int m = gw; m < T; m += NGW) {
            const float* xr = m < TP ? a.in[0] + (size_t)m * D : a.in[1] + (size_t)(m - TP) * D;
            row_norm(xr, nullptr, nullptr, nullptr, a.in[4], H + (size_t)m * D, lane);
        }
    }
    SEAM(0);
    for (int l = 0; l < DEPTH; ++l) {
        const int pb = 1 + 4 * l;
        for (int rep_ = 0; rep_ < (DUP == 1 ? 2 : 1); ++rep_)
        if (RUN(pb)) {
            pg8::Gemm g{H, W1T + (size_t)l * NIN * D, T, NIN, D}; pg8::StaticOrder S; S.init(T, NIN, G, (int)blockIdx.x);
            pg8::EpiProj E{PROJ, VSS, a.in[10] + (size_t)l * WB};
            pg8::gemm_phase<pg8::EpiProj, pg8::StaticOrder, true, true>((LAS unsigned char*)lds, g, S, E);
        }
        SEAM(pb);
        for (int rep_ = 0; rep_ < (DUP == 2 ? 2 : 1); ++rep_)
        if (RUN(pb + 1)) mix_phase(a, l, lds, gw, NGW);
        SEAM(pb + 1);
        for (int rep_ = 0; rep_ < (DUP == 3 ? 2 : 1); ++rep_)
        if (RUN(pb + 2)) {
            pg8::Gemm g{MIX, W2T + (size_t)l * D * EM, T, D, EM}; pg8::StaticOrder S; S.init(T, D, G, (int)blockIdx.x);
            pg8::EpiOutF32 E{OUT};
            pg8::gemm_phase<pg8::EpiOutF32, pg8::StaticOrder, true, true>((LAS unsigned char*)lds, g, S, E);
        }
        SEAM(pb + 2);
        if (RUN(pb + 3)) {
            int tid = threadIdx.x; asm volatile("" : "+v"(tid)); const int lane = tid & 63;
            for (int m = gw; m < T; m += NGW) {
                const float* xr = (l == 0) ? (m < TP ? a.in[0] + (size_t)m * D : a.in[1] + (size_t)(m - TP) * D) : Y + (size_t)m * D;
                row_norm(xr, OUT + (size_t)m * D, a.in[13] + (size_t)l * D, Y + (size_t)m * D,
                         a.in[4] + (size_t)(l + 1 < DEPTH ? l + 1 : 0) * D, (l + 1 < DEPTH) ? H + (size_t)m * D : nullptr, lane);
            }
        }
        SEAM(pb + 3);
    }
#undef RUN
#undef SEAM
}

#ifndef N_LAUNCH_SPLIT
#define N_LAUNCH_SPLIT 0
#endif

extern "C" void kernel_launch(void* const* d_in, const int* in_sizes, int n_in, void* d_out, int out_size, void* d_ws, size_t ws_size, hipStream_t stream) {
    static int grid = 0;
    if (grid == 0) {
        if (n_in != 14 || (size_t)out_size != O_END || ws_size < WS_END) { fprintf(stderr, "kernel_launch: unexpected sizes n_in %d out %d ws %zu (need %zu)\n", n_in, out_size, ws_size, (size_t)WS_END); grid = -1; return; }
        int dev = 0, cus = 0, per_cu = 0;
        hipGetDevice(&dev); hipDeviceGetAttribute(&cus, hipDeviceAttributeMultiprocessorCount, dev);
        if (hipFuncSetAttribute((const void*)fwd_kernel, hipFuncAttributeMaxDynamicSharedMemorySize, LDS_BYTES) != hipSuccess) { fprintf(stderr, "kernel_launch: hipFuncSetAttribute failed\n"); grid = -1; return; }
        if (hipOccupancyMaxActiveBlocksPerMultiprocessor(&per_cu, (const void*)fwd_kernel, 512, LDS_BYTES) != hipSuccess || per_cu < 1) { fprintf(stderr, "kernel_launch: occupancy query says %d\n", per_cu); per_cu = 1; }
        (void)hipGetLastError();
        grid = cus;
    }
    if (grid < 0) return;
    if (hipMemsetAsync((char*)d_ws + WS_CTL, 0, 64 * 1024, stream) != hipSuccess) { fprintf(stderr, "kernel_launch: memset failed\n"); return; }
    Args a{};
    for (int i = 0; i < 14; ++i) a.in[i] = (const float*)d_in[i];
    a.out = (float*)d_out; a.ws = (unsigned char*)d_ws;
#if N_LAUNCH_SPLIT
    for (int p = 0; p < NPHASE; ++p) { a.ph_lo = p; a.ph_hi = p + 1; hipLaunchKernelGGL(fwd_kernel, dim3(grid), dim3(512), LDS_BYTES, stream, a); }
#else
    a.ph_lo = 0; a.ph_hi = NPHASE;
    void* args[] = {&a};
    hipError_t e = hipLaunchCooperativeKernel((const void*)fwd_kernel, dim3(grid), dim3(512), args, LDS_BYTES, stream);
    if (e != hipSuccess) fprintf(stderr, "cooperative launch failed: %s (grid %d)\n", hipGetErrorString(e), grid);
#endif
}
```
